# Optimizing an MI355X kernel written in HIP

```python
import jax, jax.numpy as jnp
from jax import lax
import numpy as np

D_MODEL = 1024
BATCH = 2
SEQ = 8192
DEPTH = 4

GRID_W = 64
CTX_LEN = 256
A_GROUPS = 4
A_GROUP_DIM = 128
A_WIDTH = A_GROUPS * A_GROUP_DIM
B_WIDTH = 512
CONV_WIDTH = 31
CONV_PAD = (CONV_WIDTH - 1) // 2
AB_IN = A_WIDTH + 2 * B_WIDTH
AB_MIX = A_WIDTH + B_WIDTH
C_HEADS = 4
C_KV_HEADS = 2
C_GROUP = C_HEADS // C_KV_HEADS
C_HEAD_DIM = 128
C_WIDTH = C_HEADS * C_HEAD_DIM
C_KV_WIDTH = C_KV_HEADS * C_HEAD_DIM
D_HEADS = 4
D_NOPE = 128
D_ROPE = 64
D_V = 128
Q_LORA = 384
KV_LORA = 256
D_WIDTH = D_HEADS * D_V
CD_IN = C_WIDTH + 2 * C_KV_WIDTH + Q_LORA + KV_LORA + D_ROPE
CD_SPLITS = [C_WIDTH, C_WIDTH + C_KV_WIDTH, C_WIDTH + 2 * C_KV_WIDTH,
             C_WIDTH + 2 * C_KV_WIDTH + Q_LORA, C_WIDTH + 2 * C_KV_WIDTH + Q_LORA + KV_LORA]
CD_MIX = C_WIDTH + D_WIDTH
Q_BLOCK = 128
ROPE_THETA = 10000.0
N_GROUPS = 4
EXPERTS_PER_GROUP = 8
N_EXPERTS = N_GROUPS * EXPERTS_PER_GROUP
TOP_K = 2
EXPERT_FF = 512
EXPERT_BLOCK = 128
N_MOD = 6
RMS_EPS = 1e-6
MOD_INIT = 0.5
ROUTER_BIAS_INIT = 0.01
N_EVEN = (DEPTH + 1) // 2
N_ODD = DEPTH // 2

kernel_name = 'hybrid_fourier_conv_gqa_mla_hmoe_dit'


def rmsnorm(x, g):
    xf = x.astype(jnp.float32)
    y = xf * lax.rsqrt(jnp.mean(xf * xf, axis=-1, keepdims=True) + RMS_EPS)
    return y.astype(x.dtype) * g


def axial_rope_tables(row, col, dim):
    n_freq = dim // 4
    inv = ROPE_THETA ** (-jnp.arange(n_freq, dtype=jnp.float32) / n_freq)
    ang = jnp.concatenate([row[:, None] * inv[None, :], col[:, None] * inv[None, :]], axis=-1)
    return jnp.cos(ang), jnp.sin(ang)


def apply_rope(x, cos, sin):
    xf = x.astype(jnp.float32).reshape(x.shape[:-1] + (x.shape[-1] // 2, 2))
    xr, xi = xf[..., 0], xf[..., 1]
    c = cos[None, :, None, :]
    s = sin[None, :, None, :]
    out = jnp.stack([xr * c - xi * s, xr * s + xi * c], axis=-1)
    return out.reshape(x.shape).astype(x.dtype)


def block_attention(q, k, v, scale):
    b, s, kh, g, d = q.shape
    nb = s // Q_BLOCK
    qb = jnp.moveaxis(q.reshape(b, nb, Q_BLOCK, kh, g, d), 1, 0)

    def one_block(qblk):
        sc = jnp.einsum('bqhgd,bkhd->bhgqk', qblk, k).astype(jnp.float32) * scale
        p = jax.nn.softmax(sc, axis=-1).astype(v.dtype)
        return jnp.einsum('bhgqk,bkhe->bqhge', p, v)

    o = lax.map(one_block, qb)
    return jnp.moveaxis(o, 0, 1).reshape(b, s, kh, g, v.shape[-1])


def fourier_conv_mixer(h, w_in, conv_w, conv_b, conv_g, w_out):
    b, L, _ = h.shape
    p = h @ w_in
    pa, pu, pg = jnp.split(p, [A_WIDTH, A_WIDTH + B_WIDTH], axis=-1)
    fa = pa.astype(jnp.float32).reshape(b, L, A_GROUPS, A_GROUP_DIM)
    ya = jnp.fft.fft2(fa, axes=(1, 3), norm='ortho').real.reshape(b, L, A_WIDTH).astype(h.dtype)
    u = pu * jax.nn.sigmoid(pg)
    u = lax.conv_general_dilated(u, conv_w[:, None, :], (1,), [(CONV_PAD, CONV_PAD)],
                                 dimension_numbers=('NWC', 'WIO', 'NWC'),
                                 feature_group_count=B_WIDTH) + conv_b
    yb = jax.nn.silu(rmsnorm(u, conv_g))
    return jnp.concatenate([ya, yb], axis=-1) @ w_out


def cd_project(t, w_in, q_g, k_g, cq_g, ckv_g, w_uq, w_ukv):
    bt, L, _ = t.shape
    q, k, v, cq, ckv, kr = jnp.split(t @ w_in, CD_SPLITS, axis=-1)
    q = rmsnorm(q.reshape(bt, L, C_HEADS, C_HEAD_DIM), q_g)
    k = rmsnorm(k.reshape(bt, L, C_KV_HEADS, C_HEAD_DIM), k_g)
    v = v.reshape(bt, L, C_KV_HEADS, C_HEAD_DIM)
    qd = (rmsnorm(cq, cq_g) @ w_uq).reshape(bt, L, D_HEADS, D_NOPE + D_ROPE)
    kvd = (rmsnorm(ckv, ckv_g) @ w_ukv).reshape(bt, L, D_HEADS, D_NOPE + D_V)
    kd_rope = kr[:, :, None, :]
    return (q, k, v, qd[..., :D_NOPE], qd[..., D_NOPE:], kvd[..., :D_NOPE], kd_rope, kvd[..., D_NOPE:])


def cd_attend(q, qdn, qdr, k, v, kdn, kdr, vd):
    b, L = q.shape[:2]
    oc = block_attention(q.reshape(b, L, C_KV_HEADS, C_GROUP, C_HEAD_DIM), k, v, C_HEAD_DIM ** -0.5)
    qd = jnp.concatenate([qdn, qdr], axis=-1)[:, :, :, None, :]
    kd = jnp.concatenate([kdn, jnp.broadcast_to(kdr, kdn.shape[:-1] + (D_ROPE,))], axis=-1)
    od = block_attention(qd, kd, vd, (D_NOPE + D_ROPE) ** -0.5)
    return jnp.concatenate([oc.reshape(b, L, C_WIDTH), od.reshape(b, L, D_WIDTH)], axis=-1)


def attn_mla_mixer(h, hc, w_in, q_g, k_g, cq_g, ckv_g, w_uq, w_ukv, w_out, rope_c, rope_d, with_ctx_out):
    q, k, v, qdn, qdr, kdn, kdr, vd = cd_project(h, w_in, q_g, k_g, cq_g, ckv_g, w_uq, w_ukv)
    cq, ck, cv, cqdn, cqdr, ckdn, ckdr, cvd = cd_project(hc, w_in, q_g, k_g, cq_g, ckv_g, w_uq, w_ukv)
    q, k = apply_rope(q, *rope_c), apply_rope(k, *rope_c)
    qdr, kdr = apply_rope(qdr, *rope_d), apply_rope(kdr, *rope_d)
    cat = lambda a, b: jnp.concatenate([a, b], axis=1)
    y = cd_attend(q, qdn, qdr, cat(ck, k), cat(cv, v), cat(ckdn, kdn), cat(ckdr, kdr), cat(cvd, vd)) @ w_out
    yc = cd_attend(cq, cqdn, cqdr, ck, cv, ckdn, ckdr, cvd) @ w_out if with_ctx_out else None
    return y, yc


def routed_experts(h, e_idx, e_w, w_gate, w_up, w_down):
    n_tok, d = h.shape
    n_exp = w_gate.shape[0]
    n_asg = e_idx.shape[0] * e_idx.shape[1]
    n_blocks = (n_asg + n_exp * (EXPERT_BLOCK - 1) + EXPERT_BLOCK - 1) // EXPERT_BLOCK
    n_rows = n_blocks * EXPERT_BLOCK
    flat_e = e_idx.reshape(-1)
    flat_tok = jnp.arange(n_asg, dtype=jnp.int32) // e_idx.shape[1]
    flat_w = e_w.reshape(-1)
    order = jnp.argsort(flat_e)
    sorted_e = flat_e[order]
    counts = jnp.bincount(flat_e, length=n_exp)
    padded = (counts + EXPERT_BLOCK - 1) // EXPERT_BLOCK * EXPERT_BLOCK
    padded_end = jnp.cumsum(padded)
    start = jnp.cumsum(counts) - counts
    dest = (padded_end - padded)[sorted_e] + jnp.arange(n_asg, dtype=jnp.int32) - start[sorted_e]
    row_tok = jnp.full((n_rows,), n_tok, jnp.int32).at[dest].set(flat_tok[order])
    row_w = jnp.zeros((n_rows,), h.dtype).at[dest].set(flat_w[order])
    block_exp = jnp.minimum(jnp.searchsorted(padded_end, jnp.arange(n_blocks, dtype=jnp.int32) * EXPERT_BLOCK,
                                             side='right'), n_exp - 1)
    h_pad = jnp.concatenate([h, jnp.zeros((1, d), h.dtype)], axis=0)
    xb = h_pad[row_tok].reshape(n_blocks, EXPERT_BLOCK, d)

    def expert_block(args):
        xblk, e = args
        return (jax.nn.silu(xblk @ w_gate[e]) * (xblk @ w_up[e])) @ w_down[e]

    yb = lax.map(expert_block, (xb, block_exp)).reshape(n_rows, d)
    return jnp.zeros((n_tok + 1, d), h.dtype).at[row_tok].add(yb * row_w[:, None])[:n_tok]


def hier_moe(h, grp_w, grp_b, exp_w, exp_b, w_gate, w_up, w_down):
    n = h.shape[0]
    g_logit = (h @ grp_w).astype(jnp.float32) + grp_b.astype(jnp.float32)
    g_idx = jnp.argmax(g_logit, axis=-1).astype(jnp.int32)
    g_prob = jnp.take_along_axis(jax.nn.softmax(g_logit, axis=-1), g_idx[:, None], axis=-1)
    e_logit = ((h @ exp_w).astype(jnp.float32) + exp_b.astype(jnp.float32)).reshape(n, N_GROUPS, EXPERTS_PER_GROUP)
    e_logit = jnp.take_along_axis(e_logit, g_idx[:, None, None], axis=1)[:, 0]
    top_v, top_i = lax.top_k(e_logit, TOP_K)
    w = (g_prob * jax.nn.softmax(top_v, axis=-1)).astype(h.dtype)
    e_idx = g_idx[:, None] * EXPERTS_PER_GROUP + top_i.astype(jnp.int32)
    return routed_experts(h, e_idx, w, w_gate, w_up, w_down)


def setup_inputs(seed: int = 0) -> dict:
    key = jax.random.key(seed)
    ks = jax.random.split(key, 29)
    f32 = jnp.float32
    nrm = lambda k, shape, s: jax.random.normal(k, shape, f32) * s
    gain = lambda k, shape: 1.0 + 0.05 * jax.random.normal(k, shape, f32)
    ne, no = N_EVEN, N_ODD
    return {
        'x': nrm(ks[0], (BATCH, SEQ, D_MODEL), 1.0),
        'c': nrm(ks[1], (BATCH, D_MODEL), 1.0),
        'ctx': nrm(ks[2], (BATCH, CTX_LEN, D_MODEL), 1.0),
        'c_ctx': nrm(ks[3], (D_MODEL,), 1.0),
        'mod_w': nrm(ks[4], (DEPTH, D_MODEL, N_MOD * D_MODEL), MOD_INIT * D_MODEL ** -0.5),
        'mod_b': nrm(ks[5], (DEPTH, N_MOD * D_MODEL), 0.02),
        'norm_mix_g': gain(ks[6], (DEPTH, D_MODEL)),
        'norm_ffn_g': gain(ks[7], (DEPTH, D_MODEL)),
        'w_in_ab': nrm(ks[8], (ne, D_MODEL, AB_IN), D_MODEL ** -0.5),
        'conv_w': nrm(ks[9], (ne, CONV_WIDTH, B_WIDTH), CONV_WIDTH ** -0.5),
        'conv_b': nrm(ks[10], (ne, B_WIDTH), 0.02),
        'conv_norm_g': gain(ks[11], (ne, B_WIDTH)),
        'w_out_ab': nrm(ks[12], (ne, AB_MIX, D_MODEL), AB_MIX ** -0.5),
        'w_in_cd': nrm(ks[13], (no, D_MODEL, CD_IN), D_MODEL ** -0.5),
        'q_norm_g': gain(ks[14], (no, C_HEAD_DIM)),
        'k_norm_g': gain(ks[15], (no, C_HEAD_DIM)),
        'cq_norm_g': gain(ks[16], (no, Q_LORA)),
        'ckv_norm_g': gain(ks[17], (no, KV_LORA)),
        'w_uq': nrm(ks[18], (no, Q_LORA, D_HEADS * (D_NOPE + D_ROPE)), Q_LORA ** -0.5),
        'w_ukv': nrm(ks[19], (no, KV_LORA, D_HEADS * (D_NOPE + D_V)), KV_LORA ** -0.5),
        'w_out_cd': nrm(ks[20], (no, CD_MIX, D_MODEL), CD_MIX ** -0.5),
        'router_grp_w': nrm(ks[21], (DEPTH, D_MODEL, N_GROUPS), D_MODEL ** -0.5),
        'router_grp_b': nrm(ks[22], (DEPTH, N_GROUPS), ROUTER_BIAS_INIT),
        'router_exp_w': nrm(ks[23], (DEPTH, D_MODEL, N_EXPERTS), D_MODEL ** -0.5),
        'router_exp_b': nrm(ks[24], (DEPTH, N_EXPERTS), ROUTER_BIAS_INIT),
        'exp_w_gate': nrm(ks[25], (DEPTH, N_EXPERTS, D_MODEL, EXPERT_FF), D_MODEL ** -0.5),
        'exp_w_up': nrm(ks[26], (DEPTH, N_EXPERTS, D_MODEL, EXPERT_FF), D_MODEL ** -0.5),
        'exp_w_down': nrm(ks[27], (DEPTH, N_EXPERTS, EXPERT_FF, D_MODEL), EXPERT_FF ** -0.5),
        'final_norm_g': gain(ks[28], (D_MODEL,)),
    }


def reference(x, c, ctx, c_ctx, mod_w, mod_b, norm_mix_g, norm_ffn_g, w_in_ab, conv_w, conv_b,
              conv_norm_g, w_out_ab, w_in_cd, q_norm_g, k_norm_g, cq_norm_g, ckv_norm_g, w_uq, w_ukv,
              w_out_cd, router_grp_w, router_grp_b, router_exp_w, router_exp_b, exp_w_gate, exp_w_up,
              exp_w_down, final_norm_g):
    b, s, d = x.shape
    rows = s // GRID_W
    row_pos = jnp.repeat(jnp.arange(rows, dtype=jnp.float32), GRID_W)
    col_pos = jnp.tile(jnp.arange(GRID_W, dtype=jnp.float32), rows)
    rope_c = axial_rope_tables(row_pos, col_pos, C_HEAD_DIM)
    rope_d = axial_rope_tables(row_pos, col_pos, D_ROPE)
    silu_c = jax.nn.silu(c)
    silu_cc = jax.nn.silu(c_ctx)
    xc = ctx
    for layer in range(DEPTH):
        last = layer == DEPTH - 1
        j = layer // 2
        sh1, sc1, g1, sh2, sc2, g2 = jnp.split((silu_c @ mod_w[layer] + mod_b[layer])[:, None, :], N_MOD, axis=-1)
        csh1, csc1, cg1, csh2, csc2, cg2 = jnp.split(silu_cc @ mod_w[layer] + mod_b[layer], N_MOD)
        h = rmsnorm(x, norm_mix_g[layer]) * (1.0 + sc1) + sh1
        if layer % 2 == 0:
            ab = (w_in_ab[j], conv_w[j], conv_b[j], conv_norm_g[j], w_out_ab[j])
            x = x + g1 * fourier_conv_mixer(h, *ab)
            if not last:
                hc = rmsnorm(xc, norm_mix_g[layer]) * (1.0 + csc1) + csh1
                xc = xc + cg1 * fourier_conv_mixer(hc, *ab)
        else:
            hc = rmsnorm(xc, norm_mix_g[layer]) * (1.0 + csc1) + csh1
            y, yc = attn_mla_mixer(h, hc, w_in_cd[j], q_norm_g[j], k_norm_g[j], cq_norm_g[j], ckv_norm_g[j],
                                   w_uq[j], w_ukv[j], w_out_cd[j], rope_c, rope_d, not last)
            x = x + g1 * y
            if not last:
                xc = xc + cg1 * yc
        moe = (router_grp_w[layer], router_grp_b[layer], router_exp_w[layer], router_exp_b[layer],
               exp_w_gate[layer], exp_w_up[layer], exp_w_down[layer])
        h2 = rmsnorm(x, norm_ffn_g[layer]) * (1.0 + sc2) + sh2
        if last:
            x = x + g2 * hier_moe(h2.reshape(b * s, d), *moe).reshape(x.shape)
        else:
            hc2 = rmsnorm(xc, norm_ffn_g[layer]) * (1.0 + csc2) + csh2
            out = hier_moe(jnp.concatenate([h2.reshape(b * s, d), hc2.reshape(-1, d)], axis=0), *moe)
            x = x + g2 * out[: b * s].reshape(x.shape)
            xc = xc + cg2 * out[b * s:].reshape(xc.shape)
    return rmsnorm(x, final_norm_g)
```

```cpp
#include <hip/hip_runtime.h>
#include <hip/hip_cooperative_groups.h>
#include <hip/hip_bf16.h>
#include <cstdio>
#include <cstdint>
namespace cg = cooperative_groups;
__device__ __forceinline__ int mytid() { int t = threadIdx.x; asm volatile("" : "+v"(t)); return t; }
typedef float cv_f32x2_t __attribute__((ext_vector_type(2))); typedef __bf16 cv_bf16x2_t __attribute__((ext_vector_type(2)));
__device__ __forceinline__ unsigned cvtpk_safe(float lo, float hi) { cv_f32x2_t v = {lo, hi}; cv_bf16x2_t b = __builtin_convertvector(v, cv_bf16x2_t); return __builtin_bit_cast(unsigned, b); }
__device__ __forceinline__ float shx(float v, int lane, int o) { return __int_as_float(__builtin_amdgcn_ds_bpermute((lane ^ o) << 2, __float_as_int(v))); }
__device__ __forceinline__ int shup_i(int v, int lane, int o) { return __builtin_amdgcn_ds_bpermute((lane - o) << 2, v); }
namespace pg8 {
#define PG8_LAS __attribute__((address_space(3)))
typedef unsigned short bf16_t;
typedef short bf16x8 __attribute__((ext_vector_type(8)));
typedef float f32x4 __attribute__((ext_vector_type(4)));
typedef unsigned u32x4 __attribute__((ext_vector_type(4)));
constexpr int BM = 256, BK = 64, HALF = 128, HTB = HALF * BK * 2  , STAGE_BYTES = 8 * HTB, NXCD = 8, WGM = 8;

__host__ __device__ __forceinline__ int lds_byte(int r, int c) { const int st = (r >> 4) * 2 + (c >> 5), rr = r & 15, cc = c & 31, ob = rr * 64 + cc * 2; return st * 1024 + (ob ^ (((ob >> 9) & 1) << 5)); }
__host__ __device__ __forceinline__ void stage_rc(int b, int& R, int& C) { const int st = b / 1024, sb = b % 1024, swz = sb ^ (((sb >> 9) & 1) << 5); R = (st >> 1) * 16 + swz / 64; C = (st & 1) * 32 + (swz % 64) / 2; }
__host__ __device__ __forceinline__ int perm32(int rho) { const int n = rho >> 4, i = rho & 15; return 8 * (i >> 2) + 4 * n + (i & 3); }

struct Unit { int pm, pn, bt; };
struct Gemm { const bf16_t* A; const bf16_t* Bt; int M, N, K; };

struct StaticOrder {
    int nM, nN, nwg, G, c;
    __host__ __device__ void init(int M, int N, int G_, int c_) { nM = M / BM; nN = N / BM; nwg = nM * nN; G = G_; c = c_; }
    __host__ __device__ bool next(int i, Unit& u) const {
        const long L = (long)i * G + c; if (L >= nwg) return false;
        int wgid = (int)L; { const int q = nwg / NXCD, r = nwg % NXCD, xcd = wgid % NXCD, off = wgid / NXCD; wgid = (xcd < r ? xcd * (q + 1) : r * (q + 1) + (xcd - r) * q) + off; }
        const int nig = WGM * nN, gid = wgid / nig, fm = gid * WGM, gsz = (nM - fm) < WGM ? (nM - fm) : WGM;
        u.pm = fm + ((wgid % nig) % gsz); u.pn = (wgid % nig) / gsz; u.bt = u.pn; return true;
    }
    __device__ __forceinline__ void a_ready(const Unit&) const {}
    __device__ __forceinline__ void done(const Unit&) const {}
};
template <class Epi, class Sched, bool ALIGN_EPI = false, bool SP2 = false>
__device__ __forceinline__ void gemm_phase(PG8_LAS unsigned char* lds, const Gemm g, const Sched& S, const Epi& E) {
    const int tid = mytid(), wid = __builtin_amdgcn_readfirstlane(tid >> 6), lane = tid & 63, wr = wid >> 2, wc = wid & 3, fr = lane & 15, fq = lane >> 4;
    const int K = g.K, nt = K / BK;
    unsigned voffA[2], voffB[2];
#pragma unroll
    for (int i = 0; i < 2; ++i) { int R, C; stage_rc(tid * 16 + i * 8192, R, C); const int Rb = Epi::PERM ? ((R & ~31) + perm32(R & 31)) : R;
        voffA[i] = (unsigned)(R * K + C) * 2u; voffB[i] = (unsigned)(Rb * K + C) * 2u; }
    const size_t kstep = (size_t)(BK * 2);
    const size_t hstep = (size_t)HALF * K * 2;
    const size_t tstep = 2 * hstep;
    const unsigned ldsw = (unsigned)wid * 1024u;
    const int aoff = lds_byte(wr * 64 + fr, fq * 8), boff = lds_byte(wc * 32 + fr, fq * 8);
#define PG8_SA(b, h) (((b) * 2 + (h)) * HTB)
#define PG8_SB(b, h) ((4 + (b) * 2 + (h)) * HTB)
#define PG8_STAGE(bufoff, gbase, voff) do { _Pragma("unroll") for (int _i = 0; _i < 2; ++_i) \
        __builtin_amdgcn_global_load_lds((const unsigned*)((const char*)(gbase) + (voff)[_i]), (PG8_LAS unsigned*)(lds + (bufoff) + ldsw + _i * 8192), 16, 0, 0); } while (0)
#define PG8_LDA(dst, b, h) do { _Pragma("unroll") for (int m = 0; m < 4; ++m) _Pragma("unroll") for (int k = 0; k < 2; ++k) dst[m][k] = *(const PG8_LAS bf16x8*)(lds + PG8_SA(b, h) + aoff + m * 2048 + k * 1024); } while (0)
#define PG8_LDB(dst, b, h) do { _Pragma("unroll") for (int n = 0; n < 2; ++n) _Pragma("unroll") for (int k = 0; k < 2; ++k) dst[n][k] = *(const PG8_LAS bf16x8*)(lds + PG8_SB(b, h) + boff + n * 2048 + k * 1024); } while (0)
#define PG8_MMA(ai, bj, At, Bt) do { __builtin_amdgcn_s_setprio(1); _Pragma("unroll") for (int m = 0; m < 4; ++m) _Pragma("unroll") for (int n = 0; n < 2; ++n) _Pragma("unroll") for (int k = 0; k < 2; ++k) \
        acc[ai][bj][m][n] = __builtin_amdgcn_mfma_f32_16x16x32_bf16(Bt[n][k], At[m][k], acc[ai][bj][m][n], 0, 0, 0); __builtin_amdgcn_s_setprio(0); } while (0)
#define PG8_WAIT_V(n) asm volatile("s_waitcnt vmcnt(" #n ")" ::: "memory")
#define PG8_WAIT_L(n) asm volatile("s_waitcnt lgkmcnt(" #n ")" ::: "memory")
#define PG8_BAR __builtin_amdgcn_s_barrier()
#define PG8_SCHED __builtin_amdgcn_sched_barrier(0)
    Unit cur, nxt; int ui = 0;
    if (!S.next(0, cur)) return;
    f32x4 acc[2][2][4][2];
#pragma unroll
    for (int a = 0; a < 2; ++a)
#pragma unroll
        for (int b = 0; b < 2; ++b)
#pragma unroll
            for (int m = 0; m < 4; ++m)
#pragma unroll
                for (int n = 0; n < 2; ++n) acc[a][b][m][n] = (f32x4){0.f, 0.f, 0.f, 0.f};
    bf16x8 At[4][2], B0[2][2], B1[2][2];
    const char* cA = (const char*)g.A + (size_t)cur.pm * tstep; const char* cB = (const char*)g.Bt + (size_t)cur.bt * tstep;
    S.a_ready(cur);
    if constexpr (SP2) {
        PG8_STAGE(PG8_SB(0, 0), cB, voffB); PG8_STAGE(PG8_SB(0, 1), cB + hstep, voffB); PG8_STAGE(PG8_SA(0, 0), cA, voffA); PG8_STAGE(PG8_SA(0, 1), cA + hstep, voffA);
        if (wr == 1) PG8_BAR;
        PG8_WAIT_V(2); PG8_BAR;
        PG8_STAGE(PG8_SB(1, 0), cB + kstep, voffB); PG8_STAGE(PG8_SA(1, 0), cA + kstep, voffA); PG8_STAGE(PG8_SB(1, 1), cB + hstep + kstep, voffB);
        PG8_WAIT_V(6); PG8_BAR;
    } else {
        PG8_STAGE(PG8_SB(0, 0), cB, voffB); PG8_STAGE(PG8_SA(0, 0), cA, voffA); PG8_STAGE(PG8_SB(0, 1), cB + hstep, voffB); PG8_STAGE(PG8_SA(0, 1), cA + hstep, voffA);
        if (wr == 1) PG8_BAR;
        PG8_WAIT_V(4); PG8_BAR;
        PG8_STAGE(PG8_SB(1, 0), cB + kstep, voffB); PG8_STAGE(PG8_SA(1, 0), cA + kstep, voffA); PG8_STAGE(PG8_SB(1, 1), cB + hstep + kstep, voffB);
        PG8_WAIT_V(6); PG8_BAR;
    }
    for (;;) {
        const bool has_next = S.next(ui + 1, nxt);
        const char* nA = has_next ? (const char*)g.A + (size_t)nxt.pm * tstep : cA; const char* nB = has_next ? (const char*)g.Bt + (size_t)nxt.bt * tstep : cB;
#pragma unroll 1
        for (int t = 0; t < nt; t += 2) {
            const bool last = (t == nt - 2);
            const char* a1 = cA + (size_t)(t + 1) * kstep;
            const char* a2 = last ? nA : cA + (size_t)(t + 2) * kstep; const char* b2 = last ? nB : cB + (size_t)(t + 2) * kstep;
            const char* a3 = a2 + kstep; const char* b3 = b2 + kstep;
            if (last && has_next) S.a_ready(nxt);
            if constexpr (SP2) {
            PG8_LDB(B0, 0, 0); PG8_LDB(B1, 0, 1); PG8_SCHED; PG8_LDA(At, 0, 0); PG8_STAGE(PG8_SA(1, 1), a1 + hstep, voffA);
            PG8_WAIT_V(8); PG8_WAIT_L(0); PG8_BAR; PG8_MMA(0, 0, At, B0); PG8_MMA(0, 1, At, B1); PG8_BAR; PG8_SCHED;
            PG8_LDA(At, 0, 1); PG8_STAGE(PG8_SB(0, 0), b2, voffB); PG8_STAGE(PG8_SB(0, 1), b2 + hstep, voffB); PG8_STAGE(PG8_SA(0, 0), a2, voffA);
            PG8_WAIT_V(8); PG8_WAIT_L(0); PG8_BAR; PG8_MMA(1, 0, At, B0); PG8_MMA(1, 1, At, B1); PG8_BAR; PG8_SCHED;
            PG8_LDB(B0, 1, 0); PG8_LDB(B1, 1, 1); PG8_SCHED; PG8_LDA(At, 1, 0); PG8_STAGE(PG8_SA(0, 1), a2 + hstep, voffA);
            PG8_WAIT_V(8); PG8_WAIT_L(0); PG8_BAR; PG8_MMA(0, 0, At, B0); PG8_MMA(0, 1, At, B1); PG8_BAR; PG8_SCHED;
            PG8_LDA(At, 1, 1); PG8_STAGE(PG8_SB(1, 0), b3, voffB); PG8_STAGE(PG8_SB(1, 1), b3 + hstep, voffB); PG8_STAGE(PG8_SA(1, 0), a3, voffA);
            PG8_WAIT_V(8); PG8_WAIT_L(0); PG8_BAR; PG8_MMA(1, 0, At, B0); PG8_MMA(1, 1, At, B1); PG8_BAR; PG8_SCHED;
            } else {
            PG8_LDB(B0, 0, 0); PG8_SCHED; PG8_LDA(At, 0, 0); PG8_STAGE(PG8_SA(1, 1), a1 + hstep, voffA);
            PG8_WAIT_L(8); PG8_BAR; PG8_WAIT_L(0); PG8_MMA(0, 0, At, B0); PG8_BAR; PG8_SCHED;
            PG8_LDB(B1, 0, 1); PG8_STAGE(PG8_SB(0, 0), b2, voffB);
            PG8_BAR; PG8_WAIT_L(0); PG8_MMA(0, 1, At, B1); PG8_BAR;
            PG8_LDA(At, 0, 1); PG8_STAGE(PG8_SA(0, 0), a2, voffA);
            PG8_BAR; PG8_WAIT_L(0); PG8_MMA(1, 0, At, B0); PG8_BAR; PG8_SCHED;
            PG8_STAGE(PG8_SB(0, 1), b2 + hstep, voffB);
            PG8_WAIT_V(6); PG8_BAR; PG8_MMA(1, 1, At, B1); PG8_BAR;
            PG8_LDB(B0, 1, 0); PG8_SCHED; PG8_LDA(At, 1, 0); PG8_STAGE(PG8_SA(0, 1), a2 + hstep, voffA);
            PG8_WAIT_L(8); PG8_BAR; PG8_WAIT_L(0); PG8_MMA(0, 0, At, B0); PG8_BAR; PG8_SCHED;
            PG8_LDB(B1, 1, 1); PG8_STAGE(PG8_SB(1, 0), b3, voffB);
            PG8_BAR; PG8_WAIT_L(0); PG8_MMA(0, 1, At, B1); PG8_BAR;
            PG8_LDA(At, 1, 1); PG8_STAGE(PG8_SA(1, 0), a3, voffA);
            PG8_BAR; PG8_WAIT_L(0); PG8_MMA(1, 0, At, B0); PG8_BAR; PG8_SCHED;
            PG8_STAGE(PG8_SB(1, 1), b3 + hstep, voffB);
            PG8_WAIT_V(6); PG8_BAR; PG8_MMA(1, 1, At, B1); PG8_BAR;
            }
        }
        if constexpr (ALIGN_EPI) { if (wr == 0) PG8_BAR; }
        if constexpr (!Epi::AFTER_DRAIN) { E(acc, cur, wr, wc, fr, fq); S.done(cur); }
        if (!has_next) break;
#pragma unroll
        for (int a = 0; a < 2; ++a)
#pragma unroll
            for (int b = 0; b < 2; ++b)
#pragma unroll
                for (int m = 0; m < 4; ++m)
#pragma unroll
                    for (int n = 0; n < 2; ++n) acc[a][b][m][n] = (f32x4){0.f, 0.f, 0.f, 0.f};
        cur = nxt; cA = nA; cB = nB; ++ui;
        if constexpr (ALIGN_EPI) { if (wr == 1) PG8_BAR; }
    }
    PG8_WAIT_V(0);
    if constexpr (!ALIGN_EPI) { if (wr == 0) PG8_BAR; }
    PG8_BAR;
    if constexpr (Epi::AFTER_DRAIN) { E.fused(acc, cur, wr, wc, fr, fq, lds, wid, lane); S.done(cur); }
#undef PG8_SA
#undef PG8_SB
#undef PG8_STAGE
#undef PG8_LDA
#undef PG8_LDB
#undef PG8_MMA
#undef PG8_WAIT_V
#undef PG8_WAIT_L
#undef PG8_BAR
#undef PG8_SCHED
}
}
namespace pg8 {
typedef float f32x2 __attribute__((ext_vector_type(2)));
typedef unsigned u32x2 __attribute__((ext_vector_type(2)));
__device__ __forceinline__ unsigned cvt_pk_bf16(float lo, float hi) { return cvtpk_safe(lo, hi); }
__device__ __forceinline__ u32x4 pack8(f32x4 a, f32x4 b) { u32x4 w; w.x = cvt_pk_bf16(a[0], a[1]); w.y = cvt_pk_bf16(a[2], a[3]); w.z = cvt_pk_bf16(b[0], b[1]); w.w = cvt_pk_bf16(b[2], b[3]); return w; }
__device__ __forceinline__ float sigmoidf_(float x) { return __builtin_amdgcn_rcpf(1.0f + __expf(-x)); }
struct EpiPlain {
    static constexpr bool PERM = true, AFTER_DRAIN = false;
    bf16_t* O; int ldc;
    __device__ __forceinline__ void operator()(const f32x4 (&acc)[2][2][4][2], const Unit& u, int wr, int wc, int fr, int fq) const {
        const int row0 = u.pm * BM + wr * 64 + fr, col0 = u.pn * BM + wc * 32 + 8 * fq;
#pragma unroll
        for (int ai = 0; ai < 2; ++ai)
#pragma unroll
            for (int m = 0; m < 4; ++m) { bf16_t* rowp = O + (size_t)(row0 + ai * HALF + m * 16) * ldc + col0;
#pragma unroll
                for (int bj = 0; bj < 2; ++bj) *(u32x4*)(rowp + bj * HALF) = pack8(acc[ai][bj][m][0], acc[ai][bj][m][1]); }
    }
};
struct EpiInAB {
    static constexpr bool PERM = true, AFTER_DRAIN = false;
    bf16_t* PA; bf16_t* U;
    __device__ __forceinline__ void operator()(const f32x4 (&acc)[2][2][4][2], const Unit& u, int wr, int wc, int fr, int fq) const {
        const int row0 = u.pm * BM + wr * 64 + fr, cw = wc * 32 + 8 * fq;
        if (u.pn < 2) {
#pragma unroll
            for (int ai = 0; ai < 2; ++ai)
#pragma unroll
                for (int m = 0; m < 4; ++m) { bf16_t* rowp = PA + (size_t)(row0 + ai * HALF + m * 16) * 512 + u.pn * BM + cw;
#pragma unroll
                    for (int bj = 0; bj < 2; ++bj) *(u32x4*)(rowp + bj * HALF) = pack8(acc[ai][bj][m][0], acc[ai][bj][m][1]); }
        } else {
#pragma unroll
            for (int ai = 0; ai < 2; ++ai)
#pragma unroll
                for (int m = 0; m < 4; ++m) { bf16_t* rowp = U + (size_t)(row0 + ai * HALF + m * 16) * 512 + (u.pn - 2) * HALF + cw;
                    f32x4 v[2];
#pragma unroll
                    for (int n = 0; n < 2; ++n)
#pragma unroll
                        for (int i = 0; i < 4; ++i) v[n][i] = acc[ai][0][m][n][i] * sigmoidf_(acc[ai][1][m][n][i]);
                    *(u32x4*)rowp = pack8(v[0], v[1]); }
        }
    }
};
struct EpiGU {
    static constexpr bool PERM = true, AFTER_DRAIN = false;
    bf16_t* HID;
    __device__ __forceinline__ void operator()(const f32x4 (&acc)[2][2][4][2], const Unit& u, int wr, int wc, int fr, int fq) const {
        const int row0 = u.pm * BM + wr * 64 + fr, cw = u.pn * HALF + wc * 32 + 8 * fq;
#pragma unroll
        for (int ai = 0; ai < 2; ++ai)
#pragma unroll
            for (int m = 0; m < 4; ++m) { bf16_t* rowp = HID + (size_t)(row0 + ai * HALF + m * 16) * 512 + cw;
                f32x4 v[2];
#pragma unroll
                for (int n = 0; n < 2; ++n)
#pragma unroll
                    for (int i = 0; i < 4; ++i) { const float g = acc[ai][0][m][n][i]; v[n][i] = g * sigmoidf_(g) * acc[ai][1][m][n][i]; }
                *(u32x4*)rowp = pack8(v[0], v[1]); }
    }
};
struct EpiRes {
    static constexpr bool PERM = false, AFTER_DRAIN = false;
    float* X; const float* gate;
    __device__ __forceinline__ void operator()(const f32x4 (&acc)[2][2][4][2], const Unit& u, int wr, int wc, int fr, int fq) const {
        const int row0 = u.pm * BM + wr * 64 + fr, col0 = u.pn * BM + wc * 32 + 4 * fq;
        const int cls = u.pm < 32 ? 0 : (u.pm < 64 ? 1 : 2);
        f32x4 gv[2][2];
#pragma unroll
        for (int bj = 0; bj < 2; ++bj)
#pragma unroll
            for (int n = 0; n < 2; ++n) gv[bj][n] = *(const f32x4*)(gate + cls * 6144 + col0 + bj * HALF + n * 16);
#pragma unroll
        for (int ai = 0; ai < 2; ++ai)
#pragma unroll
            for (int m = 0; m < 4; ++m) { float* rowp = X + (size_t)(row0 + ai * HALF + m * 16) * 1024 + col0;
#pragma unroll
                for (int bj = 0; bj < 2; ++bj)
#pragma unroll
                    for (int n = 0; n < 2; ++n) { f32x4* p = (f32x4*)(rowp + bj * HALF + n * 16); *p = *p + gv[bj][n] * acc[ai][bj][m][n]; } }
    }
};
struct EpiUq {
    static constexpr bool PERM = true, AFTER_DRAIN = false;
    bf16_t* QD; const float* cosD; const float* sinD;
    __device__ __forceinline__ void operator()(const f32x4 (&acc)[2][2][4][2], const Unit& u, int wr, int wc, int fr, int fq) const {
        const int row0 = u.pm * BM + wr * 64 + fr, colb = u.pn * BM + wc * 32 + 8 * fq;
        const int d0_ = colb % 192, d1_ = (colb + HALF) % 192;
        const bool lat = u.pm < 64;
        const int po0 = (lat && d0_ >= 128) ? ((d0_ - 128) >> 1) : -1, po1 = (lat && d1_ >= 128) ? ((d1_ - 128) >> 1) : -1;
#pragma unroll
        for (int ai = 0; ai < 2; ++ai)
#pragma unroll
            for (int m = 0; m < 4; ++m) { const int row = row0 + ai * HALF + m * 16, pos = row & 8191;
#pragma unroll
                for (int bj = 0; bj < 2; ++bj) { const int po = bj ? po1 : po0;
                    f32x4 a = acc[ai][bj][m][0], b = acc[ai][bj][m][1];
                    if (po >= 0) { const f32x4 c4 = *(const f32x4*)(cosD + pos * 32 + po), s4 = *(const f32x4*)(sinD + pos * 32 + po);
                        const f32x4 a0 = a, b0 = b;
                        a[0] = a0[0] * c4[0] - a0[1] * s4[0]; a[1] = a0[0] * s4[0] + a0[1] * c4[0]; a[2] = a0[2] * c4[1] - a0[3] * s4[1]; a[3] = a0[2] * s4[1] + a0[3] * c4[1];
                        b[0] = b0[0] * c4[2] - b0[1] * s4[2]; b[1] = b0[0] * s4[2] + b0[1] * c4[2]; b[2] = b0[2] * c4[3] - b0[3] * s4[3]; b[3] = b0[2] * s4[3] + b0[3] * c4[3]; }
                    *(u32x4*)(QD + (size_t)row * 768 + colb + bj * HALF) = pack8(a, b); }
                asm volatile("" ::: "memory"); }
    }
};
__device__ __forceinline__ int keyrow_of(int r) { return r < 16384 ? ((r >> 13) * 8448 + 256 + (r & 8191)) : (((r - 16384) >> 8) * 8448 + ((r - 16384) & 255)); }
struct EpiUkv {
    static constexpr bool PERM = true, AFTER_DRAIN = false;
    bf16_t* Kdn; bf16_t* Vd;
    __device__ __forceinline__ void operator()(const f32x4 (&acc)[2][2][4][2], const Unit& u, int wr, int wc, int fr, int fq) const {
        const int row0 = u.pm * BM + wr * 64 + fr, cw = u.pn * HALF + wc * 32 + 8 * fq;
#pragma unroll
        for (int ai = 0; ai < 2; ++ai)
#pragma unroll
            for (int m = 0; m < 4; ++m) { const size_t kr = (size_t)keyrow_of(row0 + ai * HALF + m * 16) * 512 + cw;
                *(u32x4*)(Kdn + kr) = pack8(acc[ai][0][m][0], acc[ai][0][m][1]);
                *(u32x4*)(Vd + kr) = pack8(acc[ai][1][m][0], acc[ai][1][m][1]); }
    }
};
struct GroupedOrder {
    const PG8_LAS int* tstart;
    int ntiles, G, c;
    __device__ __forceinline__ bool next(int i, Unit& u) const {
        const int L = i * G + c; if (L >= ntiles * 4) return false;
        const int tile = L >> 2, pn = L & 3;
        int e = 0;
#pragma unroll 1
        for (int j = 1; j < 32; ++j) e += (tstart[j] <= tile) ? 1 : 0;
        u.pm = tile; u.pn = pn; u.bt = e * 4 + pn; return true;
    }
    __device__ __forceinline__ void a_ready(const Unit&) const {}
    __device__ __forceinline__ void done(const Unit&) const {}
};
}
namespace att {
using bf16 = __hip_bfloat16;
using bf16x8 = __attribute__((ext_vector_type(8))) short;
using s16x4  = __attribute__((ext_vector_type(4))) short;
using f32x16 = __attribute__((ext_vector_type(16))) float;
using u32x4  = __attribute__((ext_vector_type(4))) unsigned;
constexpr int NW = 8, QBLK = 32, KVBLK = 64;
constexpr float THR = 8.f;
constexpr size_t SHM_V = KVBLK * 128 * 2, SHM_K = KVBLK * 128 * 2, SHM_KR = KVBLK * 64 * 2;
constexpr size_t OFF_V = 0, OFF_K = 2 * SHM_V, OFF_KR = OFF_K + 2 * SHM_K, OFF_WS = OFF_KR + 2 * SHM_KR, OFF_QR = OFF_WS + NW * 64 * 4, SHM_ATTN = OFF_QR + NW * 4096;
#define KSWZ(row, colB) ((row) * 256 + ((colB) ^ (((row) & 7) << 4)))
#define KRSWZ(row, ch) ((row) * 128 + ((((ch) ^ (((row) >> 1) & 7))) << 4))
#define SBAR() __builtin_amdgcn_sched_barrier(0)
__device__ __forceinline__ int crow(int r, int hi) { return (r & 3) + 8 * (r >> 2) + 4 * hi; }
__device__ __forceinline__ unsigned cvtpk(float lo, float hi) { unsigned r; asm volatile("v_cvt_pk_bf16_f32 %0, %1, %2" : "=v"(r) : "v"(lo), "v"(hi)); return r; }
__device__ __forceinline__ bf16x8 ld8(const bf16* p) { return *reinterpret_cast<const bf16x8*>(p); }
template <typename T> __device__ __forceinline__ T* uni(T* p) { const unsigned long long v = (unsigned long long)p; const unsigned lo = __builtin_amdgcn_readfirstlane((unsigned)v), hi = __builtin_amdgcn_readfirstlane((unsigned)(v >> 32)); return (T*)(((unsigned long long)hi << 32) | lo); }

template <bool MLA> struct Cfg {
  static constexpr float SCALE = MLA ? 0.07216878364870322f : 0.08838834764831845f;
  static constexpr int NQ = 8;
};
template <bool MLA>
__device__ __forceinline__ void partialSM(f32x16& p0, f32x16& p1, float& m_reg, float& mn, float& alpha) {
  constexpr float SCALE = Cfg<MLA>::SCALE, C = SCALE * 1.4426950408889634f;
  float pmax = p0[0]; for (int r = 1; r < 16; ++r) pmax = fmaxf(pmax, p0[r]); for (int r = 0; r < 16; ++r) pmax = fmaxf(pmax, p1[r]);
  { auto rr = __builtin_amdgcn_permlane32_swap(__float_as_uint(pmax), __float_as_uint(pmax), false, false);
    pmax = fmaxf(__uint_as_float(rr[0]), __uint_as_float(rr[1])); }
  if (__builtin_expect(__all(pmax - m_reg <= THR / SCALE), 1)) { mn = m_reg; alpha = 1.f; }
  else { mn = fmaxf(m_reg, pmax); alpha = __builtin_amdgcn_exp2f((m_reg - mn) * C); m_reg = mn; }
  float mnC = -mn * C;
  for (int r = 0; r < 16; ++r) p0[r] = fmaf(p0[r], C, mnC); for (int r = 0; r < 16; ++r) p1[r] = fmaf(p1[r], C, mnC);
  for (int r = 0; r < 16; ++r) p0[r] = __builtin_amdgcn_exp2f(p0[r]);
}
__device__ __forceinline__ void finishSM(f32x16& p0, f32x16& p1, float alpha, float& l_reg, bf16x8& pa0, bf16x8& pa1, bf16x8& pa2, bf16x8& pa3) {
  for (int r = 0; r < 16; ++r) p1[r] = __builtin_amdgcn_exp2f(p1[r]);
  float ps = 0; for (int r = 0; r < 16; ++r) ps += p0[r]; for (int r = 0; r < 16; ++r) ps += p1[r];
  { auto rr = __builtin_amdgcn_permlane32_swap(__float_as_uint(ps), __float_as_uint(ps), false, false);
    ps = __uint_as_float(rr[0]) + __uint_as_float(rr[1]); }
  l_reg = l_reg * alpha + ps;
#define PK4(P, BASE, OUT) do { unsigned a0 = cvtpk(P[BASE + 0], P[BASE + 1]), a1 = cvtpk(P[BASE + 2], P[BASE + 3]);   \
    unsigned b0 = cvtpk(P[BASE + 4], P[BASE + 5]), b1 = cvtpk(P[BASE + 6], P[BASE + 7]);                              \
    auto r0 = __builtin_amdgcn_permlane32_swap(a0, b0, false, false); auto r1 = __builtin_amdgcn_permlane32_swap(a1, b1, false, false); \
    u32x4 w = {r0[0], r1[0], r0[1], r1[1]}; OUT = *reinterpret_cast<bf16x8*>(&w); } while (0)
  PK4(p0, 0, pa0); PK4(p0, 8, pa1); PK4(p1, 0, pa2); PK4(p1, 8, pa3);
#undef PK4
}
template <bool MLA>
__device__ __forceinline__ void qkt(f32x16& p0, f32x16& p1, const char* Ks, const char* Krs, const bf16x8* qr, const char* qrl, int r32, int hi) {
  p0 = f32x16{}; p1 = f32x16{};
#pragma unroll
  for (int d0 = 0; d0 < 8; ++d0) { int cb = (d0 * 16 + hi * 8) * 2;
    bf16x8 b0 = *reinterpret_cast<const bf16x8*>(Ks + KSWZ(r32, cb));
    bf16x8 b1 = *reinterpret_cast<const bf16x8*>(Ks + KSWZ(32 + r32, cb));
    p0 = __builtin_amdgcn_mfma_f32_32x32x16_bf16(b0, qr[d0], p0, 0, 0, 0);
    p1 = __builtin_amdgcn_mfma_f32_32x32x16_bf16(b1, qr[d0], p1, 0, 0, 0); }
  if constexpr (MLA) {
#pragma unroll
    for (int d0 = 0; d0 < 4; ++d0) { int ch = d0 * 2 + hi;
      bf16x8 b0 = *reinterpret_cast<const bf16x8*>(Krs + KRSWZ(r32, ch));
      bf16x8 b1 = *reinterpret_cast<const bf16x8*>(Krs + KRSWZ(32 + r32, ch));
      const bf16x8 qf = *reinterpret_cast<const bf16x8*>(qrl + KRSWZ(r32, ch));
      p0 = __builtin_amdgcn_mfma_f32_32x32x16_bf16(b0, qf, p0, 0, 0, 0);
      p1 = __builtin_amdgcn_mfma_f32_32x32x16_bf16(b1, qf, p1, 0, 0, 0); }
  }
}
__device__ __forceinline__ int v_st(int k, int c) { const int kk = (k & ~0xC) | ((k & 4) << 1) | ((k & 8) >> 1); return ((kk >> 3) * 4 + (c >> 5)) * 512 + ((kk & 7) * 32 + (c & 31)) * 2; }
__device__ __forceinline__ int v_rd_base(int lane) { return ((lane & 3) << 3) | (((lane >> 2) & 3) << 6) | (((lane >> 4) & 1) << 5) | (((lane >> 5) & 1) << 8); }
constexpr int v_rd_off(int d0, int ks, int half) { return d0 * 512 + ks * 4096 + half * 2048; }
template <int OFF> __device__ __forceinline__ s16x4 tr_read(int vb) {
  s16x4 r; asm volatile("ds_read_b64_tr_b16 %0, %1 offset:%2" : "=&v"(r) : "v"(vb), "i"(OFF) : "memory"); return r;
}
template <int D0> __device__ __forceinline__ void pv_one(f32x16& od, int vb, bf16x8 pa0, bf16x8 pa1, bf16x8 pa2, bf16x8 pa3) {
  const s16x4 l0 = tr_read<v_rd_off(D0, 0, 0)>(vb), h0 = tr_read<v_rd_off(D0, 0, 1)>(vb), l1 = tr_read<v_rd_off(D0, 1, 0)>(vb), h1 = tr_read<v_rd_off(D0, 1, 1)>(vb);
  const s16x4 l2 = tr_read<v_rd_off(D0, 2, 0)>(vb), h2 = tr_read<v_rd_off(D0, 2, 1)>(vb), l3 = tr_read<v_rd_off(D0, 3, 0)>(vb), h3 = tr_read<v_rd_off(D0, 3, 1)>(vb);
  asm volatile("s_waitcnt lgkmcnt(0)" ::: "memory"); SBAR();
#define PK(L, H) (bf16x8){L[0], L[1], L[2], L[3], H[0], H[1], H[2], H[3]}
  od = __builtin_amdgcn_mfma_f32_32x32x16_bf16(pa0, PK(l0, h0), od, 0, 0, 0);
  od = __builtin_amdgcn_mfma_f32_32x32x16_bf16(pa1, PK(l1, h1), od, 0, 0, 0);
  od = __builtin_amdgcn_mfma_f32_32x32x16_bf16(pa2, PK(l2, h2), od, 0, 0, 0);
  od = __builtin_amdgcn_mfma_f32_32x32x16_bf16(pa3, PK(l3, h3), od, 0, 0, 0);
#undef PK
}
__device__ __forceinline__ void pv_d0(f32x16* o, int vb, bf16x8 pa0, bf16x8 pa1, bf16x8 pa2, bf16x8 pa3) {
  pv_one<0>(o[0], vb, pa0, pa1, pa2, pa3); pv_one<1>(o[1], vb, pa0, pa1, pa2, pa3); pv_one<2>(o[2], vb, pa0, pa1, pa2, pa3); pv_one<3>(o[3], vb, pa0, pa1, pa2, pa3);
}
template <bool MLA, int LDQ, int LDK, int LDO>
__device__ __forceinline__ void attn_unit(const bf16* __restrict__ Qb, const bf16* __restrict__ Kh, const bf16* __restrict__ Krh, const bf16* __restrict__ Vh,
                                          bf16* __restrict__ Ob, int seq, char* lds) {
  constexpr int NQ = Cfg<MLA>::NQ;
  const int tid = mytid(), wid = tid >> 6, lane = tid & 63, r32 = lane & 31, hi = lane >> 5;
  char* V_lds = lds + OFF_V; char* K_lds = lds + OFF_K; char* KR_lds = lds + OFF_KR;
  float* ws = (float*)(lds + OFF_WS) + wid * 64; float* li_l = ws; float* al_l = ws + 32;
  float m_reg = -1e30f, l_reg = 0; f32x16 o[4] = {}; bf16x8 qr[NQ];
  const bf16* Qw = Qb + (long)(wid * QBLK + r32) * LDQ + hi * 8;
#pragma unroll
  for (int d0 = 0; d0 < NQ; ++d0) qr[d0] = ld8(Qw + d0 * 16);
  char* qrl = lds + OFF_QR + wid * 4096;
  if constexpr (MLA) {
#pragma unroll
    for (int d0 = 0; d0 < 4; ++d0) *reinterpret_cast<bf16x8*>(qrl + KRSWZ(r32, d0 * 2 + hi)) = ld8(Qw + 128 + d0 * 16);
  }
  const int sr = tid >> 4, sc = (tid & 15) * 8, vst0 = v_st(sr, sc), vst1 = v_st(32 + sr, sc);
  const int krr = tid >> 3, krc = tid & 7, krst = KRSWZ(krr, krc);
  const int vb0 = (int)(uintptr_t)V_lds + v_rd_base(lane);
  constexpr int SDEPTH = MLA ? 1 : 2;
  struct { bf16x8 vs0, vs1, ks0, ks1, kr; } sr_[SDEPTH];
#define SLOAD(i, k0) do { sr_[i].vs0 = ld8(&Vh[(long)((k0) + sr) * LDK + sc]); sr_[i].vs1 = ld8(&Vh[(long)((k0) + 32 + sr) * LDK + sc]); \
    sr_[i].ks0 = ld8(&Kh[(long)((k0) + sr) * LDK + sc]); sr_[i].ks1 = ld8(&Kh[(long)((k0) + 32 + sr) * LDK + sc]); \
    if constexpr (MLA) sr_[i].kr = ld8(&Krh[(long)((k0) + krr) * 64 + krc * 8]); } while (0)
#define SWRITE(b, i) do { *(bf16x8*)(V_lds + (b) * SHM_V + vst0) = sr_[i].vs0;          \
    *(bf16x8*)(V_lds + (b) * SHM_V + vst1) = sr_[i].vs1; int kc = sc * 2;               \
    *(bf16x8*)(K_lds + (b) * SHM_K + KSWZ(sr, kc)) = sr_[i].ks0;                       \
    *(bf16x8*)(K_lds + (b) * SHM_K + KSWZ(32 + sr, kc)) = sr_[i].ks1;                  \
    if constexpr (MLA) *(bf16x8*)(KR_lds + (b) * SHM_KR + krst) = sr_[i].kr; } while (0)
#define SWAIT() do { if constexpr (SDEPTH == 2) asm volatile("s_waitcnt vmcnt(4)" ::: "memory"); else asm volatile("s_waitcnt vmcnt(0)" ::: "memory"); } while (0)
#define RESC(a) do { if (__any((a) < 1.f)) { if (hi == 0) al_l[r32] = (a); asm volatile("s_waitcnt lgkmcnt(0)" ::: "memory"); \
    for (int d = 0; d < 4; ++d) for (int r = 0; r < 16; ++r) o[d][r] *= al_l[crow(r, hi)]; } } while (0)
  f32x16 pA0, pA1, pB0, pB1; float mnA, mnB, alA, alB; bf16x8 pa0, pa1, pa2, pa3; const int NT = seq / KVBLK;
  constexpr int SE = 0, SO = SDEPTH - 1;
  SLOAD(SE, 0); asm volatile("s_waitcnt vmcnt(0)" ::: "memory"); SWRITE(0, SE); __syncthreads();
  qkt<MLA>(pA0, pA1, K_lds, KR_lds, qr, qrl, r32, hi); partialSM<MLA>(pA0, pA1, m_reg, mnA, alA);
  SLOAD(SO, KVBLK); if constexpr (SDEPTH == 2) { if (2 < NT) SLOAD(SE, 2 * KVBLK); }
  SWAIT(); SWRITE(1, SO); __syncthreads();
  for (int j = 1; j + 1 < NT; j += 2) {
    SBAR(); qkt<MLA>(pB0, pB1, K_lds + SHM_K, KR_lds + SHM_KR, qr, qrl, r32, hi);
    finishSM(pA0, pA1, alA, l_reg, pa0, pa1, pa2, pa3); SBAR();
    SLOAD(SO, (j + SDEPTH) * KVBLK); SBAR();
    pv_d0(o, vb0, pa0, pa1, pa2, pa3); partialSM<MLA>(pB0, pB1, m_reg, mnB, alB);
    __syncthreads(); SWAIT(); SWRITE(0, SE);
    RESC(alB); __syncthreads();
    SBAR(); qkt<MLA>(pA0, pA1, K_lds, KR_lds, qr, qrl, r32, hi);
    finishSM(pB0, pB1, alB, l_reg, pa0, pa1, pa2, pa3); SBAR();
    if (SDEPTH == 1 || j + 3 < NT) SLOAD(SE, (j + 1 + SDEPTH) * KVBLK); SBAR();
    pv_d0(o, vb0 + (int)SHM_V, pa0, pa1, pa2, pa3); partialSM<MLA>(pA0, pA1, m_reg, mnA, alA);
    __syncthreads(); SWAIT(); SWRITE(1, SO);
    RESC(alA); __syncthreads();
  }
  SBAR(); qkt<MLA>(pB0, pB1, K_lds + SHM_K, KR_lds + SHM_KR, qr, qrl, r32, hi);
  finishSM(pA0, pA1, alA, l_reg, pa0, pa1, pa2, pa3); SBAR();
  pv_d0(o, vb0, pa0, pa1, pa2, pa3); partialSM<MLA>(pB0, pB1, m_reg, mnB, alB);
  __syncthreads(); RESC(alB);
  finishSM(pB0, pB1, alB, l_reg, pa0, pa1, pa2, pa3); SBAR();
  pv_d0(o, vb0 + (int)SHM_V, pa0, pa1, pa2, pa3);
  if (hi == 0) li_l[r32] = l_reg; asm volatile("s_waitcnt lgkmcnt(0)" ::: "memory");
  float rli[16];
#pragma unroll
  for (int r = 0; r < 16; ++r) rli[r] = __builtin_amdgcn_rcpf(li_l[crow(r, hi)]);
  bf16* Ow = Ob + (long)(wid * QBLK) * LDO;
#pragma unroll
  for (int r = 0; r < 16; ++r) { int orow = crow(r, hi);
#pragma unroll
    for (int d0 = 0; d0 < 4; ++d0) Ow[(long)orow * LDO + d0 * 32 + r32] = __float2bfloat16(o[d0][r] * rli[r]); }
  __syncthreads();
#undef SLOAD
#undef SWRITE
#undef SWAIT
#undef RESC
}

template <bool MLA, int LDQ, int LDK, int LDO>
__device__ __forceinline__ void attn_unit_simple(const bf16* __restrict__ Qb, const bf16* __restrict__ Kh, const bf16* __restrict__ Krh, const bf16* __restrict__ Vh,
                                                 bf16* __restrict__ Ob, int seq, char* lds) {
  const int tid = mytid(), wid = tid >> 6, lane = tid & 63, r32 = lane & 31, hi = lane >> 5;
  char* V_lds = lds + OFF_V; char* K_lds = lds + OFF_K; char* KR_lds = lds + OFF_KR;
  float* ws = (float*)(lds + OFF_WS) + wid * 64; float* li_l = ws; float* al_l = ws + 32;
  float m_reg = -1e30f, l_reg = 0; f32x16 o[4] = {}; bf16x8 qr[8];
  const bf16* Qw = Qb + (long)(wid * QBLK + r32) * LDQ + hi * 8;
#pragma unroll
  for (int d0 = 0; d0 < 8; ++d0) qr[d0] = ld8(Qw + d0 * 16);
  char* qrl = lds + OFF_QR + wid * 4096;
  if constexpr (MLA) {
#pragma unroll
    for (int d0 = 0; d0 < 4; ++d0) *reinterpret_cast<bf16x8*>(qrl + KRSWZ(r32, d0 * 2 + hi)) = ld8(Qw + 128 + d0 * 16);
  }
  const int sr = tid >> 4, sc = (tid & 15) * 8, vst0 = v_st(sr, sc), vst1 = v_st(32 + sr, sc);
  const int krr = tid >> 3, krc = tid & 7, krst = KRSWZ(krr, krc);
  const int vb0 = (int)(uintptr_t)V_lds + v_rd_base(lane);
  bf16x8 vs0, vs1, ks0, ks1, krs;
#define SLOAD(k0) do { vs0 = ld8(&Vh[(long)((k0) + sr) * LDK + sc]); vs1 = ld8(&Vh[(long)((k0) + 32 + sr) * LDK + sc]); \
    ks0 = ld8(&Kh[(long)((k0) + sr) * LDK + sc]); ks1 = ld8(&Kh[(long)((k0) + 32 + sr) * LDK + sc]); \
    if constexpr (MLA) krs = ld8(&Krh[(long)((k0) + krr) * 64 + krc * 8]); } while (0)
#define SWRITE(b) do { *(bf16x8*)(V_lds + (b) * SHM_V + vst0) = vs0; *(bf16x8*)(V_lds + (b) * SHM_V + vst1) = vs1; int kc = sc * 2; \
    *(bf16x8*)(K_lds + (b) * SHM_K + KSWZ(sr, kc)) = ks0; *(bf16x8*)(K_lds + (b) * SHM_K + KSWZ(32 + sr, kc)) = ks1; \
    if constexpr (MLA) *(bf16x8*)(KR_lds + (b) * SHM_KR + krst) = krs; } while (0)
  const int NT = seq / KVBLK;
  SLOAD(0); SWRITE(0); __syncthreads();
#pragma unroll 1
  for (int j = 0; j < NT; ++j) {
    const int b = j & 1;
    if (j + 1 < NT) SLOAD((j + 1) * KVBLK);
    f32x16 p0, p1; float mn, al; bf16x8 pa0, pa1, pa2, pa3;
    SBAR(); qkt<MLA>(p0, p1, K_lds + b * SHM_K, KR_lds + b * SHM_KR, qr, qrl, r32, hi);
    partialSM<MLA>(p0, p1, m_reg, mn, al);
    if (__any(al < 1.f)) { if (hi == 0) al_l[r32] = al; asm volatile("s_waitcnt lgkmcnt(0)" ::: "memory");
#pragma unroll
      for (int d = 0; d < 4; ++d)
#pragma unroll
        for (int r = 0; r < 16; ++r) o[d][r] *= al_l[crow(r, hi)]; }
    finishSM(p0, p1, al, l_reg, pa0, pa1, pa2, pa3); SBAR();
    pv_d0(o, vb0 + b * (int)SHM_V, pa0, pa1, pa2, pa3);
    if (j + 1 < NT) SWRITE(b ^ 1);
    __syncthreads();
  }
  if (hi == 0) li_l[r32] = l_reg; asm volatile("s_waitcnt lgkmcnt(0)" ::: "memory");
  float rli[16];
#pragma unroll
  for (int r = 0; r < 16; ++r) rli[r] = __builtin_amdgcn_rcpf(li_l[crow(r, hi)]);
  bf16* Ow = Ob + (long)(wid * QBLK) * LDO;
#pragma unroll
  for (int r = 0; r < 16; ++r) { int orow = crow(r, hi);
#pragma unroll
    for (int d0 = 0; d0 < 4; ++d0) Ow[(long)orow * LDO + d0 * 32 + r32] = __float2bfloat16(o[d0][r] * rli[r]); }
  __syncthreads();
#undef SLOAD
#undef SWRITE
}
#undef KSWZ
#undef KRSWZ
#undef SBAR
}
namespace fx {
typedef unsigned short bf16_t;
typedef short bf16x8 __attribute__((ext_vector_type(8)));
typedef float f32x4 __attribute__((ext_vector_type(4)));
typedef unsigned u32x4 __attribute__((ext_vector_type(4)));
typedef unsigned u32x2 __attribute__((ext_vector_type(2)));
__device__ __forceinline__ unsigned cvtpk(float lo, float hi) { return cvtpk_safe(lo, hi); }
__device__ __forceinline__ float bf2f(unsigned short h) { return __uint_as_float(((unsigned)h) << 16); }
constexpr int LD128 = 136 * 2, LD256 = 264 * 2;
constexpr int R0 = 0, R1 = 256 * LD128;
__device__ __forceinline__ void g2l(char* lds, int ldb, const bf16_t* g, size_t gld, int rows, int cols) {
    const int cpr = cols >> 3, n = rows * cpr;
    for (int i = mytid(); i < n; i += 512) { const int r = i / cpr, ch = i - r * cpr;
        *(u32x4*)(lds + r * ldb + ch * 16) = *(const u32x4*)(g + (size_t)r * gld + ch * 8); }
}
__device__ __forceinline__ void f1_item(char* lds, const bf16_t* PA, const bf16_t* DA, const bf16_t* CS, bf16_t* T, int tok0, int tstride, int g, int n2, int N2, int Ltot, int seqg) {
    const int tid = mytid(), w = tid >> 6, lane = tid & 63, fr = lane & 15, fq = lane >> 4;
    for (int i = tid; i < 128 * 16; i += 512) { const int r = i >> 4, ch = i & 15;
        *(u32x4*)(lds + R0 + r * LD128 + ch * 16) = *(const u32x4*)(PA + (size_t)(tok0 + r * tstride) * 512 + g * 128 + ch * 8); }
    g2l(lds + R1, LD128, DA, 128, 256, 128);
    __builtin_amdgcn_sched_barrier(0); __syncthreads(); __builtin_amdgcn_sched_barrier(0);
    f32x4 acc[8][2];
#pragma unroll
    for (int rt = 0; rt < 8; ++rt) { acc[rt][0] = (f32x4){0.f, 0.f, 0.f, 0.f}; acc[rt][1] = (f32x4){0.f, 0.f, 0.f, 0.f}; }
#pragma unroll
    for (int ks = 0; ks < 4; ++ks) {
        bf16x8 b[2], a[8];
#pragma unroll
        for (int ct = 0; ct < 2; ++ct) b[ct] = *(const bf16x8*)(lds + R1 + (32 * w + 16 * ct + fr) * LD128 + (32 * ks + 8 * fq) * 2);
#pragma unroll
        for (int rt = 0; rt < 8; ++rt) a[rt] = *(const bf16x8*)(lds + R0 + (16 * rt + fr) * LD128 + (32 * ks + 8 * fq) * 2);
#pragma unroll
        for (int rt = 0; rt < 8; ++rt)
#pragma unroll
            for (int ct = 0; ct < 2; ++ct) acc[rt][ct] = __builtin_amdgcn_mfma_f32_16x16x32_bf16(a[rt], b[ct], acc[rt][ct], 0, 0, 0);
    }
    __builtin_amdgcn_sched_barrier(0); __syncthreads(); __builtin_amdgcn_sched_barrier(0);
#pragma unroll
    for (int rt = 0; rt < 8; ++rt)
#pragma unroll
        for (int ct = 0; ct < 2; ++ct) { u32x2 v; v.x = cvtpk(acc[rt][ct][0], acc[rt][ct][1]); v.y = cvtpk(acc[rt][ct][2], acc[rt][ct][3]);
            *(u32x2*)(lds + R0 + (32 * w + 16 * ct + fr) * LD128 + (16 * rt + 4 * fq) * 2) = v; }
    g2l(lds + R1, LD256, CS, 256, 128, 256);
    __builtin_amdgcn_sched_barrier(0); __syncthreads(); __builtin_amdgcn_sched_barrier(0);
    f32x4 ar[8], ai[8];
#pragma unroll
    for (int rt = 0; rt < 8; ++rt) { ar[rt] = (f32x4){0.f, 0.f, 0.f, 0.f}; ai[rt] = (f32x4){0.f, 0.f, 0.f, 0.f}; }
#pragma unroll
    for (int ks = 0; ks < 8; ++ks) {
        const int part = ks >> 2, n1o = (32 * (ks & 3) + 8 * fq) * 2;
        const bf16x8 cfr = *(const bf16x8*)(lds + R1 + (16 * w + fr) * LD256 + n1o);
        const bf16x8 sfr = *(const bf16x8*)(lds + R1 + (16 * w + fr) * LD256 + 256 + n1o);
        bf16x8 nsfr;
#pragma unroll
        for (int i = 0; i < 8; ++i) nsfr[i] = (short)(sfr[i] ^ (short)0x8000);
        const bf16x8 br = part == 0 ? cfr : sfr, bi = part == 0 ? nsfr : cfr;
        bf16x8 a[8];
#pragma unroll
        for (int rt = 0; rt < 8; ++rt) a[rt] = *(const bf16x8*)(lds + R0 + (part * 128 + 16 * rt + fr) * LD128 + n1o);
#pragma unroll
        for (int rt = 0; rt < 8; ++rt) { ar[rt] = __builtin_amdgcn_mfma_f32_16x16x32_bf16(a[rt], br, ar[rt], 0, 0, 0); ai[rt] = __builtin_amdgcn_mfma_f32_16x16x32_bf16(a[rt], bi, ai[rt], 0, 0, 0); }
    }
    const int k1 = 16 * w + fr;
    const float frac = (float)((n2 * k1) % Ltot) / (float)Ltot;
    const float ct_ = __builtin_amdgcn_cosf(frac), st_ = __builtin_amdgcn_sinf(frac);
    bf16_t* Trow = T + ((size_t)(seqg * 128 + k1) * N2 + n2) * 256;
#pragma unroll
    for (int rt = 0; rt < 8; ++rt) { f32x4 tr, ti;
#pragma unroll
        for (int i = 0; i < 4; ++i) { tr[i] = ar[rt][i] * ct_ + ai[rt][i] * st_; ti[i] = ai[rt][i] * ct_ - ar[rt][i] * st_; }
        u32x2 v; v.x = cvtpk(tr[0], tr[1]); v.y = cvtpk(tr[2], tr[3]); *(u32x2*)(Trow + 16 * rt + 4 * fq) = v;
        v.x = cvtpk(ti[0], ti[1]); v.y = cvtpk(ti[2], ti[3]); *(u32x2*)(Trow + 128 + 16 * rt + 4 * fq) = v; }
    __builtin_amdgcn_sched_barrier(0); __syncthreads(); __builtin_amdgcn_sched_barrier(0);
}
__device__ __forceinline__ void f2_item(char* lds, const bf16_t* T, const bf16_t* W2, bf16_t* MIX, int seqg, int k1, bool load_w2) {
    const int tid = mytid(), w = tid >> 6, lane = tid & 63, fr = lane & 15, fq = lane >> 4;
    const bf16_t* slab = T + (size_t)(seqg * 128 + k1) * 64 * 256;
    for (int i = tid; i < 64 * 32; i += 512) { const int row = i >> 5, ch = i & 31, part = ch >> 4, m0 = (ch & 15) * 8;
        const bf16x8 v = *(const bf16x8*)(slab + (size_t)row * 256 + ch * 8);
#pragma unroll
        for (int j = 0; j < 8; ++j) *(short*)(lds + R0 + (m0 + j) * LD128 + (part * 64 + row) * 2) = v[j]; }
    if (load_w2) g2l(lds + R1, LD128, W2, 128, 64, 128);
    __builtin_amdgcn_sched_barrier(0); __syncthreads(); __builtin_amdgcn_sched_barrier(0);
    f32x4 acc[4];
#pragma unroll
    for (int ct = 0; ct < 4; ++ct) acc[ct] = (f32x4){0.f, 0.f, 0.f, 0.f};
#pragma unroll
    for (int ks = 0; ks < 4; ++ks) {
        const bf16x8 a = *(const bf16x8*)(lds + R0 + (16 * w + fr) * LD128 + (32 * ks + 8 * fq) * 2);
#pragma unroll
        for (int ct = 0; ct < 4; ++ct) { const bf16x8 b = *(const bf16x8*)(lds + R1 + (16 * ct + fr) * LD128 + (32 * ks + 8 * fq) * 2);
            acc[ct] = __builtin_amdgcn_mfma_f32_16x16x32_bf16(a, b, acc[ct], 0, 0, 0); }
    }
    const int b = seqg >> 2, g = seqg & 3;
#pragma unroll
    for (int ct = 0; ct < 4; ++ct) { const int k2 = 16 * ct + fr; u32x2 v; v.x = cvtpk(acc[ct][0], acc[ct][1]); v.y = cvtpk(acc[ct][2], acc[ct][3]);
        *(u32x2*)(MIX + (size_t)(b * 8192 + k1 + 128 * k2) * 1024 + g * 128 + 16 * w + 4 * fq) = v; }
    __builtin_amdgcn_sched_barrier(0); __syncthreads(); __builtin_amdgcn_sched_barrier(0);
}
__device__ __forceinline__ void conv_item(char* lds, const bf16_t* U, const float* cw, const float* cb, const float* cg, bf16_t* MIX, int t0, int s0, int s1) {
    const int tid = mytid(), w = tid >> 6, lane = tid & 63;
    for (int i = tid; i < 62 * 64; i += 512) { const int r = i >> 6, ch = i & 63, tok = t0 - 15 + r;
        u32x4 v = (u32x4){0u, 0u, 0u, 0u}; if (tok >= s0 && tok < s1) v = *(const u32x4*)(U + (size_t)tok * 512 + ch * 8);
        *(u32x4*)(lds + R0 + r * 1024 + ch * 16) = v; }
    for (int i = tid; i < 31 * 128; i += 512) *(f32x4*)(lds + R1 + i * 16) = *(const f32x4*)(cw + i * 4);
    __builtin_amdgcn_sched_barrier(0); __syncthreads(); __builtin_amdgcn_sched_barrier(0);
    const int c0 = lane * 8;
    f32x4 bias0 = *(const f32x4*)(cb + c0), bias1 = *(const f32x4*)(cb + c0 + 4), g0 = *(const f32x4*)(cg + c0), g1 = *(const f32x4*)(cg + c0 + 4);
#pragma unroll 1
    for (int tt = 0; tt < 4; ++tt) { const int t = 4 * w + tt;
        f32x4 a0 = bias0, a1 = bias1;
#pragma unroll 2
        for (int j = 0; j < 31; ++j) { const bf16x8 uv = *(const bf16x8*)(lds + R0 + (t + j) * 1024 + c0 * 2);
            const f32x4 w0 = *(const f32x4*)(lds + R1 + (j * 512 + c0) * 4), w1 = *(const f32x4*)(lds + R1 + (j * 512 + c0 + 4) * 4);
            a0[0] += bf2f((unsigned short)uv[0]) * w0[0]; a0[1] += bf2f((unsigned short)uv[1]) * w0[1]; a0[2] += bf2f((unsigned short)uv[2]) * w0[2]; a0[3] += bf2f((unsigned short)uv[3]) * w0[3];
            a1[0] += bf2f((unsigned short)uv[4]) * w1[0]; a1[1] += bf2f((unsigned short)uv[5]) * w1[1]; a1[2] += bf2f((unsigned short)uv[6]) * w1[2]; a1[3] += bf2f((unsigned short)uv[7]) * w1[3]; }
        float ss = (a0[0] * a0[0] + a0[1] * a0[1]) + (a0[2] * a0[2] + a0[3] * a0[3]) + (a1[0] * a1[0] + a1[1] * a1[1]) + (a1[2] * a1[2] + a1[3] * a1[3]);
#pragma unroll
        for (int o = 1; o < 64; o <<= 1) ss += shx(ss, lane, o);
        const float rstd = rsqrtf(ss * (1.0f / 512.0f) + 1e-6f);
        f32x4 y0 = a0 * rstd * g0, y1 = a1 * rstd * g1;
#pragma unroll
        for (int i = 0; i < 4; ++i) { y0[i] = y0[i] * __builtin_amdgcn_rcpf(1.0f + __expf(-y0[i])); y1[i] = y1[i] * __builtin_amdgcn_rcpf(1.0f + __expf(-y1[i])); }
        u32x4 o4; o4.x = cvtpk(y0[0], y0[1]); o4.y = cvtpk(y0[2], y0[3]); o4.z = cvtpk(y1[0], y1[1]); o4.w = cvtpk(y1[2], y1[3]);
        *(u32x4*)(MIX + (size_t)(t0 + t) * 1024 + 512 + c0) = o4; }
    __builtin_amdgcn_sched_barrier(0); __syncthreads(); __builtin_amdgcn_sched_barrier(0);
}
}
constexpr int DM = 1024, SEQ = 8192, CTXL = 256, NLAT = 2 * SEQ, NROWS = NLAT + 2 * CTXL;
constexpr int KEYS = SEQ + CTXL;
constexpr int NEXP = 32, MAXTILES = 168, XGROWS = MAXTILES * 256;
constexpr float EPS = 1e-6f;
constexpr size_t al256(size_t x) { return (x + 255) / 256 * 256; }
constexpr size_t WS_CTL = 0;
constexpr size_t WS_MODV = 65536;
constexpr size_t WS_COSC = al256(WS_MODV + 4 * 3 * 6144 * 4);
constexpr size_t WS_SINC = WS_COSC + 8192 * 64 * 4;
constexpr size_t WS_COSD = WS_SINC + 8192 * 64 * 4;
constexpr size_t WS_SIND = WS_COSD + 8192 * 32 * 4;
constexpr size_t WS_DA = WS_SIND + 8192 * 32 * 4;
constexpr size_t WS_CS = WS_DA + 256 * 128 * 2;
constexpr size_t WS_W2 = WS_CS + 128 * 256 * 2;
constexpr size_t WS_RWT = WS_W2 + 64 * 128 * 2;
constexpr size_t WS_WINAB = al256(WS_RWT + 4 * 36 * 1024 * 4);
constexpr size_t WS_WOUTAB = WS_WINAB + (size_t)2 * 1536 * 1024 * 2;
constexpr size_t WS_WINCD = WS_WOUTAB + (size_t)2 * 1024 * 1024 * 2;
constexpr size_t WS_WUQ = WS_WINCD + (size_t)2 * 1792 * 1024 * 2;
constexpr size_t WS_WUKV = WS_WUQ + (size_t)2 * 768 * 384 * 2;
constexpr size_t WS_WOUTCD = WS_WUKV + (size_t)2 * 1024 * 256 * 2;
constexpr size_t WS_WGU = WS_WOUTCD + (size_t)2 * 1024 * 1024 * 2;
constexpr size_t WS_WD = WS_WGU + (size_t)4 * 32 * 1024 * 1024 * 2;
constexpr size_t WS_X = WS_WD + (size_t)4 * 32 * 1024 * 512 * 2;
constexpr size_t WS_H = WS_X + (size_t)NROWS * 1024 * 4;
constexpr size_t WS_MIX = WS_H + (size_t)NROWS * 1024 * 2;
constexpr size_t WS_P = WS_MIX + (size_t)NROWS * 1024 * 2;
constexpr size_t WS_T = WS_P + (size_t)NROWS * 1792 * 2;
constexpr size_t WS_TC = WS_T + (size_t)8 * 128 * 64 * 256 * 2;
constexpr size_t WS_ODD = WS_T;
constexpr size_t WS_QC = WS_ODD;
constexpr size_t WS_KC = WS_QC + (size_t)NROWS * 512 * 2;
constexpr size_t WS_VC = WS_KC + (size_t)2 * KEYS * 256 * 2;
constexpr size_t WS_CQ = WS_VC + (size_t)2 * KEYS * 256 * 2;
constexpr size_t WS_CKV = WS_CQ + (size_t)NROWS * 384 * 2;
constexpr size_t WS_KDR = WS_CKV + (size_t)NROWS * 256 * 2;
constexpr size_t WS_QD = WS_KDR + (size_t)2 * KEYS * 64 * 2;
constexpr size_t WS_KDN = WS_QD + (size_t)NROWS * 768 * 2;
constexpr size_t WS_VD = WS_KDN + (size_t)2 * KEYS * 512 * 2;
constexpr size_t WS_ODD_END = WS_VD + (size_t)2 * KEYS * 512 * 2;
constexpr size_t WS_EVEN_END = WS_TC + (size_t)8 * 128 * 2 * 256 * 2;
constexpr size_t WS_RES = al256(WS_ODD_END > WS_EVEN_END ? WS_ODD_END : WS_EVEN_END);
constexpr size_t WS_RW = WS_RES + (size_t)NROWS * 2 * 4;
constexpr size_t WS_XG = al256(WS_RW + (size_t)NROWS * 2 * 4);
constexpr size_t WS_HID = WS_XG + (size_t)XGROWS * 1024 * 2;
constexpr size_t WS_Y = WS_HID + (size_t)XGROWS * 512 * 2;
constexpr size_t WS_END = WS_Y + (size_t)XGROWS * 1024 * 2;
constexpr int LDS_BYTES = 147456, MISC_OFF = 139264;
typedef unsigned short bf16_t;
typedef float f32x4 __attribute__((ext_vector_type(4)));
typedef unsigned u32x4 __attribute__((ext_vector_type(4)));
typedef unsigned u32x2 __attribute__((ext_vector_type(2)));
typedef short bf16x8 __attribute__((ext_vector_type(8)));

struct Args { const float* in[29]; float* out; unsigned char* ws; int ph_lo, ph_hi; };
typedef const __attribute__((address_space(4))) Args* KArgs;
__device__ __forceinline__ KArgs kargs() { KArgs p = (KArgs)__builtin_amdgcn_kernarg_segment_ptr(); asm volatile("" : "+s"(p)); return p; }

__device__ __forceinline__ float wave_sum(float v, int lane) {
#pragma unroll
    for (int o = 1; o < 64; o <<= 1) v += shx(v, lane, o);
    return v;
}
__device__ __forceinline__ unsigned pk2(float lo, float hi) { return cvtpk_safe(lo, hi); }
__device__ __forceinline__ float bf_lo(unsigned w) { return __uint_as_float(w << 16); }
__device__ __forceinline__ float bf_hi(unsigned w) { return __uint_as_float(w & 0xffff0000u); }
__device__ __forceinline__ int cls_of(int r) { return r < SEQ ? 0 : (r < NLAT ? 1 : 2); }
__device__ __forceinline__ void compute_tstart(int* tstart, const int* cnt) {
    const int tid_ = mytid(); if (tid_ < 64) { const int lane = tid_; int c = lane < 32 ? cnt[lane] : 0; int nt = (c + 255) >> 8, s = nt;
#pragma unroll
        for (int o = 1; o < 32; o <<= 1) { int t = shup_i(s, lane, o); if (lane >= o) s += t; }
        if (lane < 32) tstart[lane] = s - nt; if (lane == 31) tstart[32] = s; }
    __syncthreads();
}
__device__ __forceinline__ void load_row(const float* p, int lane, f32x4 (&v)[4]) {
#pragma unroll
    for (int j = 0; j < 4; ++j) v[j] = *(const f32x4*)(p + 4 * lane + 256 * j);
}
__device__ __forceinline__ void moe_combine(f32x4 (&v)[4], int r, int lane, const int* res, const float* rwt, const bf16_t* Y, const int* tstart, const float* g2) {
    const int es0 = res[2 * r], es1 = res[2 * r + 1]; const float w0 = rwt[2 * r], w1 = rwt[2 * r + 1];
    const size_t row0 = (size_t)tstart[es0 >> 20] * 256 + (es0 & 0xfffff), row1 = (size_t)tstart[es1 >> 20] * 256 + (es1 & 0xfffff);
#pragma unroll
    for (int j = 0; j < 4; ++j) { const u32x2 a = *(const u32x2*)(Y + row0 * 1024 + 4 * lane + 256 * j), b = *(const u32x2*)(Y + row1 * 1024 + 4 * lane + 256 * j);
        const f32x4 g = *(const f32x4*)(g2 + 4 * lane + 256 * j);
        v[j][0] += g[0] * (w0 * bf_lo(a.x) + w1 * bf_lo(b.x)); v[j][1] += g[1] * (w0 * bf_hi(a.x) + w1 * bf_hi(b.x));
        v[j][2] += g[2] * (w0 * bf_lo(a.y) + w1 * bf_lo(b.y)); v[j][3] += g[3] * (w0 * bf_hi(a.y) + w1 * bf_hi(b.y)); }
}
__device__ __forceinline__ float row_rstd(const f32x4 (&v)[4], int lane) {
    float s = 0.f;
#pragma unroll
    for (int j = 0; j < 4; ++j) s += (v[j][0] * v[j][0] + v[j][1] * v[j][1]) + (v[j][2] * v[j][2] + v[j][3] * v[j][3]);
    return rsqrtf(wave_sum(s, lane) * (1.0f / 1024.0f) + EPS);
}
__device__ __forceinline__ void modulate(const f32x4 (&v)[4], float rstd, int lane, const float* g, const float* sc, const float* sh, f32x4 (&h)[4]) {
#pragma unroll
    for (int j = 0; j < 4; ++j) { const f32x4 gg = *(const f32x4*)(g + 4 * lane + 256 * j), s = *(const f32x4*)(sc + 4 * lane + 256 * j), b = *(const f32x4*)(sh + 4 * lane + 256 * j);
        h[j] = v[j] * rstd * gg * (1.0f + s) + b; }
}
__device__ __forceinline__ void store_row_bf16(bf16_t* p, int lane, const f32x4 (&h)[4]) {
#pragma unroll
    for (int j = 0; j < 4; ++j) { u32x2 o; o.x = pk2(h[j][0], h[j][1]); o.y = pk2(h[j][2], h[j][3]); *(u32x2*)(p + 4 * lane + 256 * j) = o; }
}
__device__ __forceinline__ void transpose_item(const float* W, int K, int N, bf16_t* WT, int k0, int n0, int drow0, float* scr, int lane) {
#pragma unroll 8
    for (int i = 0; i < 32; ++i) { const int kk = 2 * i + (lane >> 5); scr[kk * 33 + (lane & 31)] = W[(size_t)(k0 + kk) * N + n0 + (lane & 31)]; }
    asm volatile("s_waitcnt lgkmcnt(0)" ::: "memory");
    const int c = lane & 7;
#pragma unroll
    for (int j = 0; j < 4; ++j) { const int n = (lane >> 3) + 8 * j; const float* s = scr + (8 * c) * 33 + n;
        u32x4 o; o.x = pk2(s[0 * 33], s[1 * 33]); o.y = pk2(s[2 * 33], s[3 * 33]); o.z = pk2(s[4 * 33], s[5 * 33]); o.w = pk2(s[6 * 33], s[7 * 33]);
        *(u32x4*)(WT + (size_t)(drow0 + n) * K + k0 + 8 * c) = o; }
    asm volatile("s_waitcnt lgkmcnt(0)" ::: "memory");
}
__device__ __forceinline__ float cos_rev(float x) { return __builtin_amdgcn_cosf(x); }
__device__ __forceinline__ float sin_rev(float x) { return __builtin_amdgcn_sinf(x); }

__device__ __forceinline__ void prologue(KArgs a, char* lds) {
    unsigned char* ws = a->ws;
    const int tid = mytid(), lane = tid & 63, wave = tid >> 6, G = gridDim.x, bid = blockIdx.x;
    const int gt = bid * 512 + tid, GT = G * 512, gw = bid * 8 + wave, NGW = G * 8;
    if (bid == 0 && tid < 128) ((int*)(ws + WS_CTL))[tid] = 0;
    { float* sl = (float*)(lds + 73728); float* part = (float*)(lds + 73728 + 12288);
      for (int i = tid; i < 3072; i += 512) { const int cls = i >> 10, k = i & 1023; const float v = cls < 2 ? a->in[1][cls * 1024 + k] : a->in[3][k]; sl[i] = v / (1.0f + __expf(-v)); }
      __syncthreads();
      for (int item = bid; item < 384; item += G) { const int layer = item / 96, col0 = (item % 96) * 64;
          const float* Wm = a->in[4] + (size_t)layer * 1024 * 6144 + col0 + lane;
          float a0 = 0.f, a1 = 0.f, a2 = 0.f;
#pragma unroll 16
          for (int kk = 0; kk < 128; ++kk) { const int k = wave * 128 + kk; const float wv = Wm[(size_t)k * 6144]; a0 += sl[k] * wv; a1 += sl[1024 + k] * wv; a2 += sl[2048 + k] * wv; }
          part[(wave * 3 + 0) * 64 + lane] = a0; part[(wave * 3 + 1) * 64 + lane] = a1; part[(wave * 3 + 2) * 64 + lane] = a2;
          __syncthreads();
          if (tid < 192) { const int c = tid >> 6; float s = a->in[5][layer * 6144 + col0 + lane];
#pragma unroll
              for (int w8 = 0; w8 < 8; ++w8) s += part[(w8 * 3 + c) * 64 + lane];
              ((float*)(ws + WS_MODV))[((size_t)layer * 3 + c) * 6144 + col0 + lane] = s; }
          __syncthreads(); }
    }
    { float* cosC = (float*)(ws + WS_COSC); float* sinC = (float*)(ws + WS_SINC); float* cosD = (float*)(ws + WS_COSD); float* sinD = (float*)(ws + WS_SIND);
      const float L2T = 13.287712379549449f;
      for (int i = gt; i < 8192 * 64; i += GT) { const int pos = i >> 6, p = i & 63; const float rc = (p < 32) ? (float)(pos >> 6) : (float)(pos & 63);
          const float inv = exp2f(-(float)(p & 31) * (1.0f / 32.0f) * L2T), rev = rc * inv * 0.15915494309189535f; cosC[i] = cos_rev(rev); sinC[i] = sin_rev(rev); }
      for (int i = gt; i < 8192 * 32; i += GT) { const int pos = i >> 5, p = i & 31; const float rc = (p < 16) ? (float)(pos >> 6) : (float)(pos & 63);
          const float inv = exp2f(-(float)(p & 15) * (1.0f / 16.0f) * L2T), rev = rc * inv * 0.15915494309189535f; cosD[i] = cos_rev(rev); sinD[i] = sin_rev(rev); }
      bf16_t* DA = (bf16_t*)(ws + WS_DA); bf16_t* CS = (bf16_t*)(ws + WS_CS); bf16_t* W2 = (bf16_t*)(ws + WS_W2);
      const float is128 = 0.08838834764831845f;
      for (int i = gt; i < 256 * 128; i += GT) { const int j = i >> 7, c = i & 127; const float fr = (float)(((j & 127) * c) & 127) * (1.0f / 128.0f);
          const float v = (j < 128) ? cos_rev(fr) * is128 : -sin_rev(fr) * is128; DA[i] = (bf16_t)(pk2(v, 0.f) & 0xffffu); }
      for (int i = gt; i < 128 * 256; i += GT) { const int k1 = i >> 8, q = i & 255, n1 = q & 127; const float fr = (float)((k1 * n1) & 127) * (1.0f / 128.0f);
          const float v = (q < 128) ? cos_rev(fr) * is128 : sin_rev(fr) * is128; CS[i] = (bf16_t)(pk2(v, 0.f) & 0xffffu); }
      for (int i = gt; i < 64 * 128; i += GT) { const int k2 = i >> 7, q = i & 127, n2 = q & 63; const float fr = (float)((k2 * n2) & 63) * (1.0f / 64.0f);
          const float v = (q < 64) ? cos_rev(fr) * 0.125f : sin_rev(fr) * 0.125f; W2[i] = (bf16_t)(pk2(v, 0.f) & 0xffffu); }
      float* RWT = (float*)(ws + WS_RWT);
      for (int i = gt; i < 4 * 36 * 1024; i += GT) { const int l = i / (36 * 1024), rem = i - l * 36 * 1024, c = rem >> 10, k = rem & 1023;
          RWT[i] = (c < 4) ? a->in[21][((size_t)l * 1024 + k) * 4 + c] : a->in[23][((size_t)l * 1024 + k) * 32 + (c - 4)]; }
      for (int i = gt; i < 2 * 64 * 1024 / 8; i += GT) { const int j = i / (64 * 128), rem = i - j * (64 * 128);
          *(u32x4*)((bf16_t*)(ws + WS_WINCD) + (size_t)j * 1792 * 1024 + (size_t)1728 * 1024 + (size_t)rem * 8) = (u32x4){0u, 0u, 0u, 0u}; }
    }
    { float* scr = (float*)(lds + wave * 8704);
      constexpr int I0 = 2 * 768, I1 = 2 * 512, I2 = 2 * 864, I3 = 2 * 144, I4 = 2 * 128, I5 = 2 * 512, I6 = 128 * 256, I7 = 128 * 256, I8 = 128 * 256;
      constexpr int NIT = I0 + I1 + I2 + I3 + I4 + I5 + I6 + I7 + I8;
      for (int it = gw; it < NIT; it += NGW) {
          int r = it; const float* W; bf16_t* WT; int K, N, kind;
          if (r < I0) { kind = 0; const int j = r / 768; r -= j * 768; W = a->in[8] + (size_t)j * 1024 * 1536; WT = (bf16_t*)(ws + WS_WINAB) + (size_t)j * 1536 * 1024; K = 1024; N = 1536; }
          else if ((r -= I0) < I1) { kind = 1; const int j = r / 512; r -= j * 512; W = a->in[12] + (size_t)j * 1024 * 1024; WT = (bf16_t*)(ws + WS_WOUTAB) + (size_t)j * 1024 * 1024; K = 1024; N = 1024; }
          else if ((r -= I1) < I2) { kind = 1; const int j = r / 864; r -= j * 864; W = a->in[13] + (size_t)j * 1024 * 1728; WT = (bf16_t*)(ws + WS_WINCD) + (size_t)j * 1792 * 1024; K = 1024; N = 1728; }
          else if ((r -= I2) < I3) { kind = 1; const int j = r / 144; r -= j * 144; W = a->in[18] + (size_t)j * 384 * 768; WT = (bf16_t*)(ws + WS_WUQ) + (size_t)j * 768 * 384; K = 384; N = 768; }
          else if ((r -= I3) < I4) { kind = 1; const int j = r / 128; r -= j * 128; W = a->in[19] + (size_t)j * 256 * 1024; WT = (bf16_t*)(ws + WS_WUKV) + (size_t)j * 1024 * 256; K = 256; N = 1024; }
          else if ((r -= I4) < I5) { kind = 1; const int j = r / 512; r -= j * 512; W = a->in[20] + (size_t)j * 1024 * 1024; WT = (bf16_t*)(ws + WS_WOUTCD) + (size_t)j * 1024 * 1024; K = 1024; N = 1024; }
          else if ((r -= I5) < I6) { kind = 2; const int j = r >> 8; r &= 255; W = a->in[25] + (size_t)j * 1024 * 512; WT = (bf16_t*)(ws + WS_WGU) + (size_t)j * 1024 * 1024; K = 1024; N = 512; }
          else if ((r -= I6) < I7) { kind = 3; const int j = r >> 8; r &= 255; W = a->in[26] + (size_t)j * 1024 * 512; WT = (bf16_t*)(ws + WS_WGU) + (size_t)j * 1024 * 1024; K = 1024; N = 512; }
          else { r -= I7; kind = 1; const int j = r >> 8; r &= 255; W = a->in[27] + (size_t)j * 512 * 1024; WT = (bf16_t*)(ws + WS_WD) + (size_t)j * 1024 * 512; K = 512; N = 1024; }
          const int nblk = N / 32, kb = r / nblk, nb = r - kb * nblk, n0 = 32 * nb;
          int drow0 = n0;
          if (kind == 0) { if (n0 >= 512) { const int half = (n0 - 512) >> 9, q = ((n0 - 512) & 511) >> 7, rr = n0 & 127; drow0 = 512 + 256 * q + 128 * half + rr; } }
          else if (kind == 2) drow0 = 256 * (n0 >> 7) + (n0 & 127);
          else if (kind == 3) drow0 = 256 * (n0 >> 7) + 128 + (n0 & 127);
          transpose_item(W, K, N, WT, 64 * kb, n0, drow0, scr, lane);
      }
    }
}
__device__ __forceinline__ void phase_rw1(KArgs a, char* lds, int layer) {
    unsigned char* ws = a->ws; const int tid = mytid(), lane = tid & 63, wave = tid >> 6, gw = blockIdx.x * 8 + wave, NGW = gridDim.x * 8;
    float* X = (float*)(ws + WS_X); bf16_t* H = (bf16_t*)(ws + WS_H);
    int* tstart = (int*)(lds + MISC_OFF);
    if (layer > 0) compute_tstart(tstart, (const int*)(ws + WS_CTL) + (layer - 1) * 32);
    const float* modv = (const float*)(ws + WS_MODV) + (size_t)layer * 3 * 6144;
    const float* modp = (const float*)(ws + WS_MODV) + (size_t)(layer > 0 ? layer - 1 : 0) * 3 * 6144;
    for (int r = gw; r < NROWS; r += NGW) {
        const int cls = cls_of(r); f32x4 v[4];
        if (layer == 0) { load_row(r < NLAT ? a->in[0] + (size_t)r * 1024 : a->in[2] + (size_t)(r - NLAT) * 1024, lane, v); }
        else { load_row(X + (size_t)r * 1024, lane, v);
            moe_combine(v, r, lane, (const int*)(ws + WS_RES), (const float*)(ws + WS_RW), (const bf16_t*)(ws + WS_Y), tstart, modp + cls * 6144 + 5 * 1024); }
#pragma unroll
        for (int j = 0; j < 4; ++j) *(f32x4*)(X + (size_t)r * 1024 + 4 * lane + 256 * j) = v[j];
        const float rstd = row_rstd(v, lane); f32x4 h[4];
        modulate(v, rstd, lane, a->in[6] + layer * 1024, modv + cls * 6144 + 1 * 1024, modv + cls * 6144 + 0 * 1024, h);
        store_row_bf16(H + (size_t)r * 1024, lane, h);
    }
}
__device__ __forceinline__ void phase_final(KArgs a, char* lds) {
    unsigned char* ws = a->ws; const int tid = mytid(), lane = tid & 63, wave = tid >> 6, gw = blockIdx.x * 8 + wave, NGW = gridDim.x * 8;
    const float* X = (const float*)(ws + WS_X); int* tstart = (int*)(lds + MISC_OFF);
    compute_tstart(tstart, (const int*)(ws + WS_CTL) + 3 * 32);
    const float* modp = (const float*)(ws + WS_MODV) + (size_t)3 * 3 * 6144;
    for (int r = gw; r < NLAT; r += NGW) {
        const int cls = cls_of(r); f32x4 v[4]; load_row(X + (size_t)r * 1024, lane, v);
        moe_combine(v, r, lane, (const int*)(ws + WS_RES), (const float*)(ws + WS_RW), (const bf16_t*)(ws + WS_Y), tstart, modp + cls * 6144 + 5 * 1024);
        const float rstd = row_rstd(v, lane);
#pragma unroll
        for (int j = 0; j < 4; ++j) { const f32x4 g = *(const f32x4*)(a->in[28] + 4 * lane + 256 * j); *(f32x4*)(a->out + (size_t)r * 1024 + 4 * lane + 256 * j) = v[j] * rstd * g; }
    }
}
__device__ __forceinline__ void phase_rw2(KArgs a, char* lds, int layer, int nrows) {
    unsigned char* ws = a->ws; const int tid = mytid(), lane = tid & 63, wave = tid >> 6;
    const float* X = (const float*)(ws + WS_X); bf16_t* H = (bf16_t*)(ws + WS_H);
    const float* modv = (const float*)(ws + WS_MODV) + (size_t)layer * 3 * 6144;
    const float* RWT = (const float*)(ws + WS_RWT) + (size_t)layer * 36 * 1024;
    float* hs = (float*)lds; float* lg = (float*)(lds + 65536);
    int* cnt = (int*)(ws + WS_CTL) + layer * 32; int* res = (int*)(ws + WS_RES); float* rwt = (float*)(ws + WS_RW);
    for (int rg = blockIdx.x; rg < nrows / 16; rg += gridDim.x) {
#pragma unroll 1
        for (int rr = 0; rr < 2; ++rr) { const int lr = 2 * wave + rr, r = 16 * rg + lr, cls = cls_of(r);
            f32x4 v[4], h[4]; load_row(X + (size_t)r * 1024, lane, v); const float rstd = row_rstd(v, lane);
            modulate(v, rstd, lane, a->in[7] + layer * 1024, modv + cls * 6144 + 4 * 1024, modv + cls * 6144 + 3 * 1024, h);
            store_row_bf16(H + (size_t)r * 1024, lane, h);
#pragma unroll
            for (int j = 0; j < 4; ++j) *(f32x4*)(hs + lr * 1024 + 4 * lane + 256 * j) = h[j]; }
        __syncthreads();
#pragma unroll 1
        for (int q = 0; q < 5; ++q) { const int c = wave + 8 * q; if (c < 36) {
            float acc[16];
#pragma unroll
            for (int i = 0; i < 16; ++i) acc[i] = 0.f;
#pragma unroll 4
            for (int j = 0; j < 16; ++j) { const int k = lane + 64 * j; const float wv = RWT[c * 1024 + k];
#pragma unroll
                for (int i = 0; i < 16; ++i) acc[i] += wv * hs[i * 1024 + k]; }
#pragma unroll
            for (int i = 0; i < 16; ++i) { const float s = wave_sum(acc[i], lane); if (lane == 0) lg[i * 36 + c] = s; } } }
        __syncthreads();
        if (tid < 16) { const int r = 16 * rg + tid; const float* L = lg + tid * 36;
            const float* gb = a->in[22] + layer * 4; const float* eb = a->in[24] + layer * 32;
            const float g0 = L[0] + gb[0], g1 = L[1] + gb[1], g2 = L[2] + gb[2], g3 = L[3] + gb[3];
            int gi = 0; float gm = g0; if (g1 > gm) { gm = g1; gi = 1; } if (g2 > gm) { gm = g2; gi = 2; } if (g3 > gm) { gm = g3; gi = 3; }
            const float gprob = 1.0f / (expf(g0 - gm) + expf(g1 - gm) + expf(g2 - gm) + expf(g3 - gm));
            int i1 = 0; float v1 = -INFINITY;
#pragma unroll
            for (int i = 0; i < 8; ++i) { const float e = L[4 + gi * 8 + i] + eb[gi * 8 + i]; if (e > v1) { v1 = e; i1 = i; } }
            int i2 = 0; float v2 = -INFINITY;
#pragma unroll
            for (int i = 0; i < 8; ++i) { const float e = L[4 + gi * 8 + i] + eb[gi * 8 + i]; if (i != i1 && e > v2) { v2 = e; i2 = i; } }
            const float t = expf(v2 - v1), p1 = 1.0f / (1.0f + t), p2 = t / (1.0f + t);
            const int e1 = gi * 8 + i1, e2 = gi * 8 + i2;
            const int s1 = atomicAdd(cnt + e1, 1), s2 = atomicAdd(cnt + e2, 1);
            res[2 * r] = (e1 << 20) | s1; res[2 * r + 1] = (e2 << 20) | s2; rwt[2 * r] = gprob * p1; rwt[2 * r + 1] = gprob * p2; }
        __syncthreads();
    }
}
__device__ __forceinline__ void phase_gather(KArgs a, char* lds, int layer, int nrows) {
    unsigned char* ws = a->ws; const int tid = mytid(), lane = tid & 63, wave = tid >> 6, gw = blockIdx.x * 8 + wave, NGW = gridDim.x * 8;
    int* tstart = (int*)(lds + MISC_OFF); compute_tstart(tstart, (const int*)(ws + WS_CTL) + layer * 32);
    const bf16_t* H = (const bf16_t*)(ws + WS_H); bf16_t* XG = (bf16_t*)(ws + WS_XG); const int* res = (const int*)(ws + WS_RES);
    for (int r = gw; r < nrows; r += NGW) { const int es0 = res[2 * r], es1 = res[2 * r + 1];
        const size_t row0 = (size_t)tstart[es0 >> 20] * 256 + (es0 & 0xfffff), row1 = (size_t)tstart[es1 >> 20] * 256 + (es1 & 0xfffff);
        const u32x4 x0 = *(const u32x4*)(H + (size_t)r * 1024 + 8 * lane), x1 = *(const u32x4*)(H + (size_t)r * 1024 + 512 + 8 * lane);
        *(u32x4*)(XG + row0 * 1024 + 8 * lane) = x0; *(u32x4*)(XG + row0 * 1024 + 512 + 8 * lane) = x1;
        *(u32x4*)(XG + row1 * 1024 + 8 * lane) = x0; *(u32x4*)(XG + row1 * 1024 + 512 + 8 * lane) = x1; }
}
__device__ __forceinline__ void ld8f(const bf16_t* p, float (&f)[8]) { const u32x4 w = *(const u32x4*)p; f[0] = bf_lo(w.x); f[1] = bf_hi(w.x); f[2] = bf_lo(w.y); f[3] = bf_hi(w.y); f[4] = bf_lo(w.z); f[5] = bf_hi(w.z); f[6] = bf_lo(w.w); f[7] = bf_hi(w.w); }
__device__ __forceinline__ void st8f(bf16_t* p, const float (&f)[8]) { u32x4 w; w.x = pk2(f[0], f[1]); w.y = pk2(f[2], f[3]); w.z = pk2(f[4], f[5]); w.w = pk2(f[6], f[7]); *(u32x4*)p = w; }
__device__ __forceinline__ float sumsq8(const float (&f)[8]) { return (f[0] * f[0] + f[1] * f[1]) + (f[2] * f[2] + f[3] * f[3]) + (f[4] * f[4] + f[5] * f[5]) + (f[6] * f[6] + f[7] * f[7]); }
__device__ __forceinline__ void scale_g8(float (&f)[8], float rstd, const float* g) { const f32x4 g0 = *(const f32x4*)g, g1 = *(const f32x4*)(g + 4);
    f[0] *= rstd * g0[0]; f[1] *= rstd * g0[1]; f[2] *= rstd * g0[2]; f[3] *= rstd * g0[3]; f[4] *= rstd * g1[0]; f[5] *= rstd * g1[1]; f[6] *= rstd * g1[2]; f[7] *= rstd * g1[3]; }
__device__ __forceinline__ void rope8(float (&f)[8], const float* cs, const float* sn) { const f32x4 c = *(const f32x4*)cs, s = *(const f32x4*)sn;
#pragma unroll
    for (int i = 0; i < 4; ++i) { const float xr = f[2 * i], xi = f[2 * i + 1]; f[2 * i] = xr * c[i] - xi * s[i]; f[2 * i + 1] = xr * s[i] + xi * c[i]; } }
__device__ __forceinline__ void phase_qkvpost(KArgs a, int j) {
    unsigned char* ws = a->ws; const int tid = mytid(), lane = tid & 63, wave = tid >> 6, gw = blockIdx.x * 8 + wave, NGW = gridDim.x * 8;
    const bf16_t* P = (const bf16_t*)(ws + WS_P);
    bf16_t* Qc = (bf16_t*)(ws + WS_QC); bf16_t* Kc = (bf16_t*)(ws + WS_KC); bf16_t* Vc = (bf16_t*)(ws + WS_VC); bf16_t* CQ = (bf16_t*)(ws + WS_CQ); bf16_t* CKV = (bf16_t*)(ws + WS_CKV); bf16_t* Kdr = (bf16_t*)(ws + WS_KDR);
    const float* cosC = (const float*)(ws + WS_COSC); const float* sinC = (const float*)(ws + WS_SINC); const float* cosD = (const float*)(ws + WS_COSD); const float* sinD = (const float*)(ws + WS_SIND);
    const float* qg = a->in[14] + j * 128; const float* kg = a->in[15] + j * 128; const float* cqg = a->in[16] + j * 384; const float* ckvg = a->in[17] + j * 256;
    for (int r = gw; r < NROWS; r += NGW) {
        const bf16_t* Pr = P + (size_t)r * 1792; const bool rot = r < NLAT; const int pos = r & 8191; const size_t kr = (size_t)pg8::keyrow_of(r);
        float f[8];
        { ld8f(Pr + 8 * lane, f); float s = sumsq8(f); s += shx(s, lane, 1); s += shx(s, lane, 2); s += shx(s, lane, 4); s += shx(s, lane, 8);
          const int d = (8 * lane) & 127; scale_g8(f, rsqrtf(s * (1.0f / 128.0f) + EPS), qg + d);
          if (rot) rope8(f, cosC + pos * 64 + (d >> 1), sinC + pos * 64 + (d >> 1));
          st8f(Qc + (size_t)r * 512 + 8 * lane, f); }
        { ld8f(Pr + 512 + 8 * lane, f); float s = sumsq8(f); s += shx(s, lane, 1); s += shx(s, lane, 2); s += shx(s, lane, 4); s += shx(s, lane, 8);
          if (lane < 32) { const int d = (8 * lane) & 127; scale_g8(f, rsqrtf(s * (1.0f / 128.0f) + EPS), kg + d);
              if (rot) rope8(f, cosC + pos * 64 + (d >> 1), sinC + pos * 64 + (d >> 1));
              st8f(Kc + kr * 256 + 8 * lane, f); }
          else st8f(Vc + kr * 256 + 8 * (lane - 32), f); }
        { const int off = lane < 48 ? 1024 + 8 * lane : (lane < 56 ? 1664 + 8 * (lane - 48) : 0); ld8f(Pr + off, f);
          float s = lane < 48 ? sumsq8(f) : 0.f; s = wave_sum(s, lane);
          if (lane < 48) { scale_g8(f, rsqrtf(s * (1.0f / 384.0f) + EPS), cqg + 8 * lane); st8f(CQ + (size_t)r * 384 + 8 * lane, f); }
          else if (lane < 56) { if (rot) rope8(f, cosD + pos * 32 + 4 * (lane - 48), sinD + pos * 32 + 4 * (lane - 48)); st8f(Kdr + kr * 64 + 8 * (lane - 48), f); } }
        { const int off = 1408 + 8 * (lane & 31); ld8f(Pr + off, f); float s = lane < 32 ? sumsq8(f) : 0.f; s = wave_sum(s, lane);
          if (lane < 32) { scale_g8(f, rsqrtf(s * (1.0f / 256.0f) + EPS), ckvg + 8 * lane); st8f(CKV + (size_t)r * 256 + 8 * lane, f); } }
    }
}
__global__ void __launch_bounds__(512, 2) fwd_kernel(Args a_unused) {
    extern __shared__ __attribute__((aligned(16))) unsigned char lds_raw[];
    cg::grid_group grid = cg::this_grid();
    char* lds = (char*)lds_raw; PG8_LAS unsigned char* lds3 = (PG8_LAS unsigned char*)lds_raw;
    const int G = gridDim.x, bid = blockIdx.x;
    const int lo = kargs()->ph_lo, hi = kargs()->ph_hi; int ph = 0;
#ifdef ZERO_LDS
    for (int i = mytid(); i < LDS_BYTES / 16; i += 512) *(u32x4*)(lds + i * 16) = (u32x4){0u, 0u, 0u, 0u};
    __syncthreads();
#endif
#define a kargs()
#define ws (kargs()->ws)
#ifndef PHSEL
#define PHSEL -1
#endif
#define RUNK(k) (ph >= lo && ph < hi && (PHSEL < 0 || PHSEL == (k)))
#define SEAM() do { ++ph; if (ph > lo && ph < hi) { asm volatile("s_waitcnt vmcnt(0) lgkmcnt(0)" ::: "memory"); grid.sync(); } } while (0)
#define H ((bf16_t*)(ws + WS_H))
#define MIX ((bf16_t*)(ws + WS_MIX))
#define X ((float*)(ws + WS_X))
    if (RUNK(0)) prologue(a, lds);
    SEAM();
#pragma unroll 1
    for (int layer = 0; layer < 4; ++layer) {
        const int j = layer >> 1; const bool last = layer == 3;
#define modv ((const float*)(ws + WS_MODV) + (size_t)layer * 3 * 6144)
        if (RUNK(1)) phase_rw1(a, lds, layer);
        SEAM();
        if ((layer & 1) == 0) {
            bf16_t* PA = (bf16_t*)(ws + WS_P); bf16_t* U = PA + (size_t)NROWS * 512;
            if (RUNK(2)) { pg8::Gemm g{H, (const bf16_t*)(ws + WS_WINAB) + (size_t)j * 1536 * 1024, NROWS, 1536, 1024}; pg8::StaticOrder S; S.init(NROWS, 1536, G, bid);
                pg8::EpiInAB E{PA, U}; pg8::gemm_phase<pg8::EpiInAB, pg8::StaticOrder, true, true>(lds3, g, S, E); }
            SEAM();
            if (RUNK(3)) {
                const bf16_t* DA = (const bf16_t*)(ws + WS_DA); const bf16_t* CS = (const bf16_t*)(ws + WS_CS);
                for (int it = bid; it < 1056; it += G) {
                    if (it < 512) { const int seqg = it >> 6, n2 = it & 63, b = seqg >> 2, gq = seqg & 3; fx::f1_item(lds, PA, DA, CS, (bf16_t*)(ws + WS_T), b * SEQ + n2, 64, gq, n2, 64, 8192, seqg); }
                    else if (it < 528) { const int q = it - 512, seqg = q >> 1, n2 = q & 1, b = seqg >> 2, gq = seqg & 3; fx::f1_item(lds, PA, DA, CS, (bf16_t*)(ws + WS_TC), NLAT + b * CTXL + n2, 2, gq, n2, 2, 256, seqg); }
                    else { const int t0 = (it - 528) * 32; int s0, s1; if (t0 < NLAT) { s0 = t0 & ~(SEQ - 1); s1 = s0 + SEQ; } else { s0 = NLAT + ((t0 - NLAT) & ~(CTXL - 1)); s1 = s0 + CTXL; }
#ifndef NO_CONV
                        fx::conv_item(lds, U, a->in[9] + (size_t)j * 31 * 512, a->in[10] + j * 512, a->in[11] + j * 512, MIX, t0, s0, s1);
#endif
 }
                }
            }
            SEAM();
            if (RUNK(4)) {
                const bf16_t* W2 = (const bf16_t*)(ws + WS_W2); bool first = true;
                for (int it = bid; it < 1024; it += G) { fx::f2_item(lds, (const bf16_t*)(ws + WS_T), W2, MIX, it >> 7, it & 127, first); first = false; }
                const bf16_t* TC = (const bf16_t*)(ws + WS_TC);
                for (int i = bid * 512 + mytid(); i < 8 * 128 * 32; i += G * 512) { const int seqg = i >> 12, k1 = (i >> 5) & 127, m0 = (i & 31) * 4, b = seqg >> 2, gq = seqg & 3;
                    const u32x2 t0 = *(const u32x2*)(TC + ((size_t)(seqg * 128 + k1) * 2 + 0) * 256 + m0), t1 = *(const u32x2*)(TC + ((size_t)(seqg * 128 + k1) * 2 + 1) * 256 + m0);
                    const float r2 = 0.7071067811865476f; u32x2 o0, o1;
                    o0.x = pk2((bf_lo(t0.x) + bf_lo(t1.x)) * r2, (bf_hi(t0.x) + bf_hi(t1.x)) * r2); o0.y = pk2((bf_lo(t0.y) + bf_lo(t1.y)) * r2, (bf_hi(t0.y) + bf_hi(t1.y)) * r2);
                    o1.x = pk2((bf_lo(t0.x) - bf_lo(t1.x)) * r2, (bf_hi(t0.x) - bf_hi(t1.x)) * r2); o1.y = pk2((bf_lo(t0.y) - bf_lo(t1.y)) * r2, (bf_hi(t0.y) - bf_hi(t1.y)) * r2);
                    *(u32x2*)(MIX + (size_t)(NLAT + b * CTXL + k1) * 1024 + gq * 128 + m0) = o0; *(u32x2*)(MIX + (size_t)(NLAT + b * CTXL + k1 + 128) * 1024 + gq * 128 + m0) = o1; }
            }
            SEAM();
            if (RUNK(5)) { pg8::Gemm g{MIX, (const bf16_t*)(ws + WS_WOUTAB) + (size_t)j * 1024 * 1024, NROWS, 1024, 1024}; pg8::StaticOrder S; S.init(NROWS, 1024, G, bid);
                pg8::EpiRes E{X, modv + 2 * 1024}; pg8::gemm_phase<pg8::EpiRes, pg8::StaticOrder, true, true>(lds3, g, S, E); }
            SEAM();
        } else {
            bf16_t* P = (bf16_t*)(ws + WS_P);
            if (RUNK(6)) { pg8::Gemm g{H, (const bf16_t*)(ws + WS_WINCD) + (size_t)j * 1792 * 1024, NROWS, 1792, 1024}; pg8::StaticOrder S; S.init(NROWS, 1792, G, bid);
                pg8::EpiPlain E{P, 1792}; pg8::gemm_phase<pg8::EpiPlain, pg8::StaticOrder, true, true>(lds3, g, S, E); }
            SEAM();
            if (RUNK(7)) phase_qkvpost(a, j);
            SEAM();
            if (RUNK(8)) {
#ifndef NO_UQ
                { pg8::Gemm g{(const bf16_t*)(ws + WS_CQ), (const bf16_t*)(ws + WS_WUQ) + (size_t)j * 768 * 384, NROWS, 768, 384}; pg8::StaticOrder S; S.init(NROWS, 768, G, bid);
                  pg8::EpiUq E{(bf16_t*)(ws + WS_QD), (const float*)(ws + WS_COSD), (const float*)(ws + WS_SIND)}; pg8::gemm_phase<pg8::EpiUq, pg8::StaticOrder, true, true>(lds3, g, S, E); }
#endif
#ifndef NO_UKV
                { pg8::Gemm g{(const bf16_t*)(ws + WS_CKV), (const bf16_t*)(ws + WS_WUKV) + (size_t)j * 1024 * 256, NROWS, 1024, 256}; pg8::StaticOrder S; S.init(NROWS, 1024, G, bid);
                  pg8::EpiUkv E{(bf16_t*)(ws + WS_KDN), (bf16_t*)(ws + WS_VD)}; pg8::gemm_phase<pg8::EpiUkv, pg8::StaticOrder, true, true>(lds3, g, S, E); }
#endif
            }
            SEAM();
            if (RUNK(9)) {
                using att::bf16;
                const bf16* Qc = (const bf16*)(ws + WS_QC); const bf16* Kc = (const bf16*)(ws + WS_KC); const bf16* Vc = (const bf16*)(ws + WS_VC);
                const bf16* QD = (const bf16*)(ws + WS_QD); const bf16* Kdn = (const bf16*)(ws + WS_KDN); const bf16* Kdr = (const bf16*)(ws + WS_KDR); const bf16* Vd = (const bf16*)(ws + WS_VD);
                bf16* AO = (bf16*)MIX;
#ifndef NO_GQA
#pragma unroll 1
                for (int c = bid; c < 256; c += G) { const int bh = c & 7, qb = c >> 3, b = bh >> 2, h = bh & 3; const size_t qrow = (size_t)b * SEQ + qb * 256, krow = (size_t)b * KEYS;
                    att::attn_unit_simple<false, 512, 256, 1024>(Qc + qrow * 512 + h * 128, Kc + krow * 256 + (h >> 1) * 128, nullptr, Vc + krow * 256 + (h >> 1) * 128, AO + qrow * 1024 + h * 128, KEYS, lds); }
#endif
                asm volatile("" ::: "memory");
#ifndef NO_MLA
#pragma unroll 1
                for (int c = bid; c < 256; c += G) { const int bh = c & 7, qb = c >> 3, b = bh >> 2, h = bh & 3; const size_t qrow = (size_t)b * SEQ + qb * 256, krow = (size_t)b * KEYS;
                    att::attn_unit_simple<true, 768, 512, 1024>(QD + qrow * 768 + h * 192, Kdn + krow * 512 + h * 128, Kdr + krow * 64, Vd + krow * 512 + h * 128, AO + qrow * 1024 + 512 + h * 128, KEYS, lds); }
#endif
                asm volatile("" ::: "memory");
#ifndef NO_CTXQ
                if (!last)
#pragma unroll 1
                for (int c = bid; c < 16; c += G) { const int bh = c & 7, b = bh >> 2, h = bh & 3; const size_t qrow = (size_t)NLAT + b * CTXL, krow = (size_t)b * KEYS;
                    if (c < 8) att::attn_unit_simple<false, 512, 256, 1024>(Qc + qrow * 512 + h * 128, Kc + krow * 256 + (h >> 1) * 128, nullptr, Vc + krow * 256 + (h >> 1) * 128, AO + qrow * 1024 + h * 128, CTXL, lds);
                    else att::attn_unit_simple<true, 768, 512, 1024>(QD + qrow * 768 + h * 192, Kdn + krow * 512 + h * 128, Kdr + krow * 64, Vd + krow * 512 + h * 128, AO + qrow * 1024 + 512 + h * 128, CTXL, lds); }
#endif
            }
            SEAM();
            if (RUNK(10)) { pg8::Gemm g{MIX, (const bf16_t*)(ws + WS_WOUTCD) + (size_t)j * 1024 * 1024, NROWS, 1024, 1024}; pg8::StaticOrder S; S.init(last ? NLAT : NROWS, 1024, G, bid);
                pg8::EpiRes E{X, modv + 2 * 1024}; pg8::gemm_phase<pg8::EpiRes, pg8::StaticOrder, true, true>(lds3, g, S, E); }
            SEAM();
        }
        const int nrows = last ? NLAT : NROWS;
        if (RUNK(11)) phase_rw2(a, lds, layer, nrows);
        SEAM();
        if (RUNK(12)) phase_gather(a, lds, layer, nrows);
        SEAM();
        if (RUNK(13)) { int* tstart = (int*)(lds + MISC_OFF); compute_tstart(tstart, (const int*)(ws + WS_CTL) + layer * 32);
            pg8::GroupedOrder S{(const PG8_LAS int*)(lds3 + MISC_OFF), tstart[32], G, bid};
            pg8::Gemm g{(const bf16_t*)(ws + WS_XG), (const bf16_t*)(ws + WS_WGU) + (size_t)layer * 32 * 1024 * 1024, 0, 1024, 1024};
            pg8::EpiGU E{(bf16_t*)(ws + WS_HID)}; pg8::gemm_phase<pg8::EpiGU, pg8::GroupedOrder, true, true>(lds3, g, S, E); }
        SEAM();
        if (RUNK(14)) { int* tstart = (int*)(lds + MISC_OFF); compute_tstart(tstart, (const int*)(ws + WS_CTL) + layer * 32);
            pg8::GroupedOrder S{(const PG8_LAS int*)(lds3 + MISC_OFF), tstart[32], G, bid};
            pg8::Gemm g{(const bf16_t*)(ws + WS_HID), (const bf16_t*)(ws + WS_WD) + (size_t)layer * 32 * 1024 * 512, 0, 1024, 512};
            pg8::EpiPlain E{(bf16_t*)(ws + WS_Y), 1024}; pg8::gemm_phase<pg8::EpiPlain, pg8::GroupedOrder, true, true>(lds3, g, S, E); }
        SEAM();
    }
#ifdef DBG_STOP
    { asm volatile("s_waitcnt vmcnt(0) lgkmcnt(0)" ::: "memory"); grid.sync();
#ifdef DBG_BF16_OFF
      const bf16_t* Bs = (const bf16_t*)(ws + (size_t)(DBG_BF16_OFF));
      for (size_t i = (size_t)bid * 512 + mytid(); i < (size_t)NLAT * 256; i += (size_t)G * 512) { const u32x2 w = *(const u32x2*)(Bs + i * 4); *(f32x4*)(a->out + i * 4) = (f32x4){bf_lo(w.x), bf_hi(w.x), bf_lo(w.y), bf_hi(w.y)}; }
#else
      const float* Xs = (const float*)(ws + WS_X);
      for (size_t i = (size_t)bid * 512 + mytid(); i < (size_t)NLAT * 256; i += (size_t)G * 512) *(f32x4*)(a->out + i * 4) = *(const f32x4*)(Xs + i * 4);
#endif
    }
#else
    if (RUNK(15)) phase_final(a, lds);
#endif
#undef RUNK
#undef SEAM
#undef a
#undef ws
#undef H
#undef MIX
#undef X
#undef modv
}
constexpr int N_PHASES = 1 + 2 * 9 + 2 * 10 + 1;

extern "C" void kernel_launch(void* const* d_in, const int* in_sizes, int n_in, void* d_out, int out_size, void* d_ws, size_t ws_size, hipStream_t stream) {
    static int grid = 0;
    if (grid == 0) {
        if (n_in != 29 || out_size != NLAT * 1024 || ws_size < WS_END) { fprintf(stderr, "kernel_launch: unexpected shapes: n_in %d out %d ws %zu (need %zu)\n", n_in, out_size, ws_size, (size_t)WS_END); grid = -1; return; }
        int dev = 0, cus = 0, per_cu = 0;
        if (hipGetDevice(&dev) != hipSuccess || hipDeviceGetAttribute(&cus, hipDeviceAttributeMultiprocessorCount, dev) != hipSuccess) { grid = -1; return; }
        if (hipFuncSetAttribute((const void*)fwd_kernel, hipFuncAttributeMaxDynamicSharedMemorySize, LDS_BYTES) != hipSuccess) { fprintf(stderr, "kernel_launch: hipFuncSetAttribute failed\n"); grid = -1; return; }
        if (hipOccupancyMaxActiveBlocksPerMultiprocessor(&per_cu, (const void*)fwd_kernel, 512, LDS_BYTES) != hipSuccess || per_cu < 1) { fprintf(stderr, "kernel_launch: occupancy query says %d blocks per CU\n", per_cu); (void)hipGetLastError(); grid = -1; return; }
        grid = cus;
    }
    if (grid < 0) return;
    Args a{};
    for (int i = 0; i < 29; ++i) a.in[i] = (const float*)d_in[i];
    a.out = (float*)d_out; a.ws = (unsigned char*)d_ws; a.ph_lo = 0; a.ph_hi = N_PHASES;
#ifdef DBG_STOP
    a.ph_hi = DBG_STOP;
#endif
    void* args[] = {&a};
    const hipError_t e = hipLaunchCooperativeKernel((const void*)fwd_kernel, dim3(grid), dim3(512), args, LDS_BYTES, stream);
    if (e != hipSuccess) fprintf(stderr, "kernel_launch: cooperative launch failed: %s (grid %d)\n", hipGetErrorString(e), grid);
}
```

```cpp
#include <hip/hip_runtime.h>
#include <hip/hip_cooperative_groups.h>
#include <hip/hip_bf16.h>
#include <cstdio>
#include <cstdint>
namespace cg = cooperative_groups;
__device__ __forceinline__ int mytid() { int t = threadIdx.x; asm volatile("" : "+v"(t)); return t; }
typedef float cv_f32x2_t __attribute__((ext_vector_type(2))); typedef __bf16 cv_bf16x2_t __attribute__((ext_vector_type(2)));
__device__ __forceinline__ unsigned cvtpk_safe(float lo, float hi) { cv_f32x2_t v = {lo, hi}; cv_bf16x2_t b = __builtin_convertvector(v, cv_bf16x2_t); return __builtin_bit_cast(unsigned, b); }
__device__ __forceinline__ float shx(float v, int lane, int o) { return __int_as_float(__builtin_amdgcn_ds_bpermute((lane ^ o) << 2, __float_as_int(v))); }
__device__ __forceinline__ int shup_i(int v, int lane, int o) { return __builtin_amdgcn_ds_bpermute((lane - o) << 2, v); }
namespace pg8 {
#define PG8_LAS __attribute__((address_space(3)))
typedef unsigned short bf16_t;
typedef short bf16x8 __attribute__((ext_vector_type(8)));
typedef float f32x4 __attribute__((ext_vector_type(4)));
typedef unsigned u32x4 __attribute__((ext_vector_type(4)));
constexpr int BM = 256, BK = 64, HALF = 128, HTB = HALF * BK * 2  , STAGE_BYTES = 8 * HTB, NXCD = 8, WGM = 8;

__host__ __device__ __forceinline__ int lds_byte(int r, int c) { const int st = (r >> 4) * 2 + (c >> 5), rr = r & 15, cc = c & 31, ob = rr * 64 + cc * 2; return st * 1024 + (ob ^ (((ob >> 9) & 1) << 5)); }
__host__ __device__ __forceinline__ void stage_rc(int b, int& R, int& C) { const int st = b / 1024, sb = b % 1024, swz = sb ^ (((sb >> 9) & 1) << 5); R = (st >> 1) * 16 + swz / 64; C = (st & 1) * 32 + (swz % 64) / 2; }
__host__ __device__ __forceinline__ int perm32(int rho) { const int n = rho >> 4, i = rho & 15; return 8 * (i >> 2) + 4 * n + (i & 3); }

struct Unit { int pm, pn, bt; };
struct Gemm { const bf16_t* A; const bf16_t* Bt; int M, N, K; };

struct StaticOrder {
    int nM, nN, nwg, G, c;
    __host__ __device__ void init(int M, int N, int G_, int c_) { nM = M / BM; nN = N / BM; nwg = nM * nN; G = G_; c = c_; }
    __host__ __device__ bool next(int i, Unit& u) const {
        const long L = (long)i * G + c; if (L >= nwg) return false;
        int wgid = (int)L; { const int q = nwg / NXCD, r = nwg % NXCD, xcd = wgid % NXCD, off = wgid / NXCD; wgid = (xcd < r ? xcd * (q + 1) : r * (q + 1) + (xcd - r) * q) + off; }
        const int nig = WGM * nN, gid = wgid / nig, fm = gid * WGM, gsz = (nM - fm) < WGM ? (nM - fm) : WGM;
        u.pm = fm + ((wgid % nig) % gsz); u.pn = (wgid % nig) / gsz; u.bt = u.pn; return true;
    }
    __device__ __forceinline__ void a_ready(const Unit&) const {}
    __device__ __forceinline__ void done(const Unit&) const {}
};
template <class Epi, class Sched, bool ALIGN_EPI = false, bool SP2 = false>
__device__ __forceinline__ void gemm_phase(PG8_LAS unsigned char* lds, const Gemm g, const Sched& S, const Epi& E) {
    const int tid = mytid(), wid = __builtin_amdgcn_readfirstlane(tid >> 6), lane = tid & 63, wr = wid >> 2, wc = wid & 3, fr = lane & 15, fq = lane >> 4;
    const int K = g.K, nt = K / BK;
    unsigned voffA[2], voffB[2];
#pragma unroll
    for (int i = 0; i < 2; ++i) { int R, C; stage_rc(tid * 16 + i * 8192, R, C); const int Rb = Epi::PERM ? ((R & ~31) + perm32(R & 31)) : R;
        voffA[i] = (unsigned)(R * K + C) * 2u; voffB[i] = (unsigned)(Rb * K + C) * 2u; }
    const size_t kstep = (size_t)(BK * 2);
    const size_t hstep = (size_t)HALF * K * 2;
    const size_t tstep = 2 * hstep;
    const unsigned ldsw = (unsigned)wid * 1024u;
    const int aoff = lds_byte(wr * 64 + fr, fq * 8), boff = lds_byte(wc * 32 + fr, fq * 8);
#define PG8_SA(b, h) (((b) * 2 + (h)) * HTB)
#define PG8_SB(b, h) ((4 + (b) * 2 + (h)) * HTB)
#define PG8_STAGE(bufoff, gbase, voff) do { _Pragma("unroll") for (int _i = 0; _i < 2; ++_i) \
        __builtin_amdgcn_global_load_lds((const unsigned*)((const char*)(gbase) + (voff)[_i]), (PG8_LAS unsigned*)(lds + (bufoff) + ldsw + _i * 8192), 16, 0, 0); } while (0)
#define PG8_LDA(dst, b, h) do { _Pragma("unroll") for (int m = 0; m < 4; ++m) _Pragma("unroll") for (int k = 0; k < 2; ++k) dst[m][k] = *(const PG8_LAS bf16x8*)(lds + PG8_SA(b, h) + aoff + m * 2048 + k * 1024); } while (0)
#define PG8_LDB(dst, b, h) do { _Pragma("unroll") for (int n = 0; n < 2; ++n) _Pragma("unroll") for (int k = 0; k < 2; ++k) dst[n][k] = *(const PG8_LAS bf16x8*)(lds + PG8_SB(b, h) + boff + n * 2048 + k * 1024); } while (0)
#define PG8_MMA(ai, bj, At, Bt) do { __builtin_amdgcn_s_setprio(1); _Pragma("unroll") for (int m = 0; m < 4; ++m) _Pragma("unroll") for (int n = 0; n < 2; ++n) _Pragma("unroll") for (int k = 0; k < 2; ++k) \
        acc[ai][bj][m][n] = __builtin_amdgcn_mfma_f32_16x16x32_bf16(Bt[n][k], At[m][k], acc[ai][bj][m][n], 0, 0, 0); __builtin_amdgcn_s_setprio(0); } while (0)
#define PG8_WAIT_V(n) asm volatile("s_waitcnt vmcnt(" #n ")" ::: "memory")
#define PG8_WAIT_L(n) asm volatile("s_waitcnt lgkmcnt(" #n ")" ::: "memory")
#define PG8_BAR __builtin_amdgcn_s_barrier()
#define PG8_SCHED __builtin_amdgcn_sched_barrier(0)
    Unit cur, nxt; int ui = 0;
    if (!S.next(0, cur)) return;
    f32x4 acc[2][2][4][2];
#pragma unroll
    for (int a = 0; a < 2; ++a)
#pragma unroll
        for (int b = 0; b < 2; ++b)
#pragma unroll
            for (int m = 0; m < 4; ++m)
#pragma unroll
                for (int n = 0; n < 2; ++n) acc[a][b][m][n] = (f32x4){0.f, 0.f, 0.f, 0.f};
    bf16x8 At[4][2], B0[2][2], B1[2][2];
    const char* cA = (const char*)g.A + (size_t)cur.pm * tstep; const char* cB = (const char*)g.Bt + (size_t)cur.bt * tstep;
    S.a_ready(cur);
    if constexpr (SP2) {
        PG8_STAGE(PG8_SB(0, 0), cB, voffB); PG8_STAGE(PG8_SB(0, 1), cB + hstep, voffB); PG8_STAGE(PG8_SA(0, 0), cA, voffA); PG8_STAGE(PG8_SA(0, 1), cA + hstep, voffA);
        if (wr == 1) PG8_BAR;
        PG8_WAIT_V(2); PG8_BAR;
        PG8_STAGE(PG8_SB(1, 0), cB + kstep, voffB); PG8_STAGE(PG8_SA(1, 0), cA + kstep, voffA); PG8_STAGE(PG8_SB(1, 1), cB + hstep + kstep, voffB);
        PG8_WAIT_V(6); PG8_BAR;
    } else {
        PG8_STAGE(PG8_SB(0, 0), cB, voffB); PG8_STAGE(PG8_SA(0, 0), cA, voffA); PG8_STAGE(PG8_SB(0, 1), cB + hstep, voffB); PG8_STAGE(PG8_SA(0, 1), cA + hstep, voffA);
        if (wr == 1) PG8_BAR;
        PG8_WAIT_V(4); PG8_BAR;
        PG8_STAGE(PG8_SB(1, 0), cB + kstep, voffB); PG8_STAGE(PG8_SA(1, 0), cA + kstep, voffA); PG8_STAGE(PG8_SB(1, 1), cB + hstep + kstep, voffB);
        PG8_WAIT_V(6); PG8_BAR;
    }
    for (;;) {
        const bool has_next = S.next(ui + 1, nxt);
        const char* nA = has_next ? (const char*)g.A + (size_t)nxt.pm * tstep : cA; const char* nB = has_next ? (const char*)g.Bt + (size_t)nxt.bt * tstep : cB;
#pragma unroll 1
        for (int t = 0; t < nt; t += 2) {
            const bool last = (t == nt - 2);
            const char* a1 = cA + (size_t)(t + 1) * kstep;
            const char* a2 = last ? nA : cA + (size_t)(t + 2) * kstep; const char* b2 = last ? nB : cB + (size_t)(t + 2) * kstep;
            const char* a3 = a2 + kstep; const char* b3 = b2 + kstep;
            if (last && has_next) S.a_ready(nxt);
            if constexpr (SP2) {
            PG8_LDB(B0, 0, 0); PG8_LDB(B1, 0, 1); PG8_SCHED; PG8_LDA(At, 0, 0); PG8_STAGE(PG8_SA(1, 1), a1 + hstep, voffA);
            PG8_WAIT_V(8); PG8_WAIT_L(0); PG8_BAR; PG8_MMA(0, 0, At, B0); PG8_MMA(0, 1, At, B1); PG8_BAR; PG8_SCHED;
            PG8_LDA(At, 0, 1); PG8_STAGE(PG8_SB(0, 0), b2, voffB); PG8_STAGE(PG8_SB(0, 1), b2 + hstep, voffB); PG8_STAGE(PG8_SA(0, 0), a2, voffA);
            PG8_WAIT_V(8); PG8_WAIT_L(0); PG8_BAR; PG8_MMA(1, 0, At, B0); PG8_MMA(1, 1, At, B1); PG8_BAR; PG8_SCHED;
            PG8_LDB(B0, 1, 0); PG8_LDB(B1, 1, 1); PG8_SCHED; PG8_LDA(At, 1, 0); PG8_STAGE(PG8_SA(0, 1), a2 + hstep, voffA);
            PG8_WAIT_V(8); PG8_WAIT_L(0); PG8_BAR; PG8_MMA(0, 0, At, B0); PG8_MMA(0, 1, At, B1); PG8_BAR; PG8_SCHED;
            PG8_LDA(At, 1, 1); PG8_STAGE(PG8_SB(1, 0), b3, voffB); PG8_STAGE(PG8_SB(1, 1), b3 + hstep, voffB); PG8_STAGE(PG8_SA(1, 0), a3, voffA);
            PG8_WAIT_V(8); PG8_WAIT_L(0); PG8_BAR; PG8_MMA(1, 0, At, B0); PG8_MMA(1, 1, At, B1); PG8_BAR; PG8_SCHED;
            } else {
            PG8_LDB(B0, 0, 0); PG8_SCHED; PG8_LDA(At, 0, 0); PG8_STAGE(PG8_SA(1, 1), a1 + hstep, voffA);
            PG8_WAIT_L(8); PG8_BAR; PG8_WAIT_L(0); PG8_MMA(0, 0, At, B0); PG8_BAR; PG8_SCHED;
            PG8_LDB(B1, 0, 1); PG8_STAGE(PG8_SB(0, 0), b2, voffB);
            PG8_BAR; PG8_WAIT_L(0); PG8_MMA(0, 1, At, B1); PG8_BAR;
            PG8_LDA(At, 0, 1); PG8_STAGE(PG8_SA(0, 0), a2, voffA);
            PG8_BAR; PG8_WAIT_L(0); PG8_MMA(1, 0, At, B0); PG8_BAR; PG8_SCHED;
            PG8_STAGE(PG8_SB(0, 1), b2 + hstep, voffB);
            PG8_WAIT_V(6); PG8_BAR; PG8_MMA(1, 1, At, B1); PG8_BAR;
            PG8_LDB(B0, 1, 0); PG8_SCHED; PG8_LDA(At, 1, 0); PG8_STAGE(PG8_SA(0, 1), a2 + hstep, voffA);
            PG8_WAIT_L(8); PG8_BAR; PG8_WAIT_L(0); PG8_MMA(0, 0, At, B0); PG8_BAR; PG8_SCHED;
            PG8_LDB(B1, 1, 1); PG8_STAGE(PG8_SB(1, 0), b3, voffB);
            PG8_BAR; PG8_WAIT_L(0); PG8_MMA(0, 1, At, B1); PG8_BAR;
            PG8_LDA(At, 1, 1); PG8_STAGE(PG8_SA(1, 0), a3, voffA);
            PG8_BAR; PG8_WAIT_L(0); PG8_MMA(1, 0, At, B0); PG8_BAR; PG8_SCHED;
            PG8_STAGE(PG8_SB(1, 1), b3 + hstep, voffB);
            PG8_WAIT_V(6); PG8_BAR; PG8_MMA(1, 1, At, B1); PG8_BAR;
            }
        }
        if constexpr (ALIGN_EPI) { if (wr == 0) PG8_BAR; }
        if constexpr (!Epi::AFTER_DRAIN) { E(acc, cur, wr, wc, fr, fq); S.done(cur); }
        if (!has_next) break;
#pragma unroll
        for (int a = 0; a < 2; ++a)
#pragma unroll
            for (int b = 0; b < 2; ++b)
#pragma unroll
                for (int m = 0; m < 4; ++m)
#pragma unroll
                    for (int n = 0; n < 2; ++n) acc[a][b][m][n] = (f32x4){0.f, 0.f, 0.f, 0.f};
        cur = nxt; cA = nA; cB = nB; ++ui;
        if constexpr (ALIGN_EPI) { if (wr == 1) PG8_BAR; }
    }
    PG8_WAIT_V(0);
    if constexpr (!ALIGN_EPI) { if (wr == 0) PG8_BAR; }
    PG8_BAR;
    if constexpr (Epi::AFTER_DRAIN) { E.fused(acc, cur, wr, wc, fr, fq, lds, wid, lane); S.done(cur); }
#undef PG8_SA
#undef PG8_SB
#undef PG8_STAGE
#undef PG8_LDA
#undef PG8_LDB
#undef PG8_MMA
#undef PG8_WAIT_V
#undef PG8_WAIT_L
#undef PG8_BAR
#undef PG8_SCHED
}
}
namespace pg8 {
typedef float f32x2 __attribute__((ext_vector_type(2)));
typedef unsigned u32x2 __attribute__((ext_vector_type(2)));
__device__ __forceinline__ unsigned cvt_pk_bf16(float lo, float hi) { return cvtpk_safe(lo, hi); }
__device__ __forceinline__ u32x4 pack8(f32x4 a, f32x4 b) { u32x4 w; w.x = cvt_pk_bf16(a[0], a[1]); w.y = cvt_pk_bf16(a[2], a[3]); w.z = cvt_pk_bf16(b[0], b[1]); w.w = cvt_pk_bf16(b[2], b[3]); return w; }
__device__ __forceinline__ float sigmoidf_(float x) { return __builtin_amdgcn_rcpf(1.0f + __expf(-x)); }
struct EpiPlain {
    static constexpr bool PERM = true, AFTER_DRAIN = false;
    bf16_t* O; int ldc;
    __device__ __forceinline__ void operator()(const f32x4 (&acc)[2][2][4][2], const Unit& u, int wr, int wc, int fr, int fq) const {
        const int row0 = u.pm * BM + wr * 64 + fr, col0 = u.pn * BM + wc * 32 + 8 * fq;
#pragma unroll
        for (int ai = 0; ai < 2; ++ai)
#pragma unroll
            for (int m = 0; m < 4; ++m) { bf16_t* rowp = O + (size_t)(row0 + ai * HALF + m * 16) * ldc + col0;
#pragma unroll
                for (int bj = 0; bj < 2; ++bj) *(u32x4*)(rowp + bj * HALF) = pack8(acc[ai][bj][m][0], acc[ai][bj][m][1]); }
    }
};
struct EpiInAB {
    static constexpr bool PERM = true, AFTER_DRAIN = false;
    bf16_t* PA; bf16_t* U;
    __device__ __forceinline__ void operator()(const f32x4 (&acc)[2][2][4][2], const Unit& u, int wr, int wc, int fr, int fq) const {
        const int row0 = u.pm * BM + wr * 64 + fr, cw = wc * 32 + 8 * fq;
        if (u.pn < 2) {
#pragma unroll
            for (int ai = 0; ai < 2; ++ai)
#pragma unroll
                for (int m = 0; m < 4; ++m) { bf16_t* rowp = PA + (size_t)(row0 + ai * HALF + m * 16) * 512 + u.pn * BM + cw;
#pragma unroll
                    for (int bj = 0; bj < 2; ++bj) *(u32x4*)(rowp + bj * HALF) = pack8(acc[ai][bj][m][0], acc[ai][bj][m][1]); }
        } else {
#pragma unroll
            for (int ai = 0; ai < 2; ++ai)
#pragma unroll
                for (int m = 0; m < 4; ++m) { bf16_t* rowp = U + (size_t)(row0 + ai * HALF + m * 16) * 512 + (u.pn - 2) * HALF + cw;
                    f32x4 v[2];
#pragma unroll
                    for (int n = 0; n < 2; ++n)
#pragma unroll
                        for (int i = 0; i < 4; ++i) v[n][i] = acc[ai][0][m][n][i] * sigmoidf_(acc[ai][1][m][n][i]);
                    *(u32x4*)rowp = pack8(v[0], v[1]); }
        }
    }
};
struct EpiGU {
    static constexpr bool PERM = true, AFTER_DRAIN = false;
    bf16_t* HID;
    __device__ __forceinline__ void operator()(const f32x4 (&acc)[2][2][4][2], const Unit& u, int wr, int wc, int fr, int fq) const {
        const int row0 = u.pm * BM + wr * 64 + fr, cw = u.pn * HALF + wc * 32 + 8 * fq;
#pragma unroll
        for (int ai = 0; ai < 2; ++ai)
#pragma unroll
            for (int m = 0; m < 4; ++m) { bf16_t* rowp = HID + (size_t)(row0 + ai * HALF + m * 16) * 512 + cw;
                f32x4 v[2];
#pragma unroll
                for (int n = 0; n < 2; ++n)
#pragma unroll
                    for (int i = 0; i < 4; ++i) { const float g = acc[ai][0][m][n][i]; v[n][i] = g * sigmoidf_(g) * acc[ai][1][m][n][i]; }
                *(u32x4*)rowp = pack8(v[0], v[1]); }
    }
};
struct EpiRes {
    static constexpr bool PERM = false, AFTER_DRAIN = false;
    float* X; const float* gate;
    __device__ __forceinline__ void operator()(const f32x4 (&acc)[2][2][4][2], const Unit& u, int wr, int wc, int fr, int fq) const {
        const int row0 = u.pm * BM + wr * 64 + fr, col0 = u.pn * BM + wc * 32 + 4 * fq;
        const int cls = u.pm < 32 ? 0 : (u.pm < 64 ? 1 : 2);
        f32x4 gv[2][2];
#pragma unroll
        for (int bj = 0; bj < 2; ++bj)
#pragma unroll
            for (int n = 0; n < 2; ++n) gv[bj][n] = *(const f32x4*)(gate + cls * 6144 + col0 + bj * HALF + n * 16);
#pragma unroll
        for (int ai = 0; ai < 2; ++ai)
#pragma unroll
            for (int m = 0; m < 4; ++m) { float* rowp = X + (size_t)(row0 + ai * HALF + m * 16) * 1024 + col0;
#pragma unroll
                for (int bj = 0; bj < 2; ++bj)
#pragma unroll
                    for (int n = 0; n < 2; ++n) { f32x4* p = (f32x4*)(rowp + bj * HALF + n * 16); *p = *p + gv[bj][n] * acc[ai][bj][m][n]; } }
    }
};
struct EpiUq {
    static constexpr bool PERM = true, AFTER_DRAIN = false;
    bf16_t* QD; const float* cosD; const float* sinD;
    __device__ __forceinline__ void operator()(const f32x4 (&acc)[2][2][4][2], const Unit& u, int wr, int wc, int fr, int fq) const {
        const int row0 = u.pm * BM + wr * 64 + fr, colb = u.pn * BM + wc * 32 + 8 * fq;
        const int d0_ = colb % 192, d1_ = (colb + HALF) % 192;
        const bool lat = u.pm < 64;
        const int po0 = (lat && d0_ >= 128) ? ((d0_ - 128) >> 1) : -1, po1 = (lat && d1_ >= 128) ? ((d1_ - 128) >> 1) : -1;
#pragma unroll
        for (int ai = 0; ai < 2; ++ai)
#pragma unroll
            for (int m = 0; m < 4; ++m) { const int row = row0 + ai * HALF + m * 16, pos = row & 8191;
#pragma unroll
                for (int bj = 0; bj < 2; ++bj) { const int po = bj ? po1 : po0;
                    f32x4 a = acc[ai][bj][m][0], b = acc[ai][bj][m][1];
                    if (po >= 0) { const f32x4 c4 = *(const f32x4*)(cosD + pos * 32 + po), s4 = *(const f32x4*)(sinD + pos * 32 + po);
                        const f32x4 a0 = a, b0 = b;
                        a[0] = a0[0] * c4[0] - a0[1] * s4[0]; a[1] = a0[0] * s4[0] + a0[1] * c4[0]; a[2] = a0[2] * c4[1] - a0[3] * s4[1]; a[3] = a0[2] * s4[1] + a0[3] * c4[1];
                        b[0] = b0[0] * c4[2] - b0[1] * s4[2]; b[1] = b0[0] * s4[2] + b0[1] * c4[2]; b[2] = b0[2] * c4[3] - b0[3] * s4[3]; b[3] = b0[2] * s4[3] + b0[3] * c4[3]; }
                    *(u32x4*)(QD + (size_t)row * 768 + colb + bj * HALF) = pack8(a, b); }
                asm volatile("" ::: "memory"); }
    }
};
__device__ __forceinline__ int keyrow_of(int r) { return r < 16384 ? ((r >> 13) * 8448 + 256 + (r & 8191)) : (((r - 16384) >> 8) * 8448 + ((r - 16384) & 255)); }
struct EpiUkv {
    static constexpr bool PERM = true, AFTER_DRAIN = false;
    bf16_t* Kdn; bf16_t* Vd;
    __device__ __forceinline__ void operator()(const f32x4 (&acc)[2][2][4][2], const Unit& u, int wr, int wc, int fr, int fq) const {
        const int row0 = u.pm * BM + wr * 64 + fr, cw = u.pn * HALF + wc * 32 + 8 * fq;
#pragma unroll
        for (int ai = 0; ai < 2; ++ai)
#pragma unroll
            for (int m = 0; m < 4; ++m) { const size_t kr = (size_t)keyrow_of(row0 + ai * HALF + m * 16) * 512 + cw;
                *(u32x4*)(Kdn + kr) = pack8(acc[ai][0][m][0], acc[ai][0][m][1]);
                *(u32x4*)(Vd + kr) = pack8(acc[ai][1][m][0], acc[ai][1][m][1]); }
    }
};
struct GroupedOrder {
    const PG8_LAS int* tstart;
    int ntiles, G, c;
    __device__ __forceinline__ bool next(int i, Unit& u) const {
        const int L = i * G + c; if (L >= ntiles * 4) return false;
        const int tile = L >> 2, pn = L & 3;
        int e = 0;
#pragma unroll 1
        for (int j = 1; j < 32; ++j) e += (tstart[j] <= tile) ? 1 : 0;
        u.pm = tile; u.pn = pn; u.bt = e * 4 + pn; return true;
    }
    __device__ __forceinline__ void a_ready(const Unit&) const {}
    __device__ __forceinline__ void done(const Unit&) const {}
};
}
namespace att {
using bf16 = __hip_bfloat16;
using bf16x8 = __attribute__((ext_vector_type(8))) short;
using s16x4  = __attribute__((ext_vector_type(4))) short;
using f32x16 = __attribute__((ext_vector_type(16))) float;
using u32x4  = __attribute__((ext_vector_type(4))) unsigned;
constexpr int NW = 8, QBLK = 32, KVBLK = 64;
constexpr float THR = 8.f;
constexpr size_t SHM_V = KVBLK * 128 * 2, SHM_K = KVBLK * 128 * 2, SHM_KR = KVBLK * 64 * 2;
constexpr size_t OFF_V = 0, OFF_K = 2 * SHM_V, OFF_KR = OFF_K + 2 * SHM_K, OFF_WS = OFF_KR + 2 * SHM_KR, OFF_QR = OFF_WS + NW * 64 * 4, SHM_ATTN = OFF_QR + NW * 4096;
#define KSWZ(row, colB) ((row) * 256 + ((colB) ^ (((row) & 7) << 4)))
#define KRSWZ(row, ch) ((row) * 128 + ((((ch) ^ (((row) >> 1) & 7))) << 4))
#define SBAR() __builtin_amdgcn_sched_barrier(0)
__device__ __forceinline__ int crow(int r, int hi) { return (r & 3) + 8 * (r >> 2) + 4 * hi; }
__device__ __forceinline__ unsigned cvtpk(float lo, float hi) { unsigned r; asm volatile("v_cvt_pk_bf16_f32 %0, %1, %2" : "=v"(r) : "v"(lo), "v"(hi)); return r; }
__device__ __forceinline__ bf16x8 ld8(const bf16* p) { return *reinterpret_cast<const bf16x8*>(p); }
template <typename T> __device__ __forceinline__ T* uni(T* p) { const unsigned long long v = (unsigned long long)p; const unsigned lo = __builtin_amdgcn_readfirstlane((unsigned)v), hi = __builtin_amdgcn_readfirstlane((unsigned)(v >> 32)); return (T*)(((unsigned long long)hi << 32) | lo); }

template <bool MLA> struct Cfg {
  static constexpr float SCALE = MLA ? 0.07216878364870322f : 0.08838834764831845f;
  static constexpr int NQ = 8;
};
template <bool MLA>
__device__ __forceinline__ void partialSM(f32x16& p0, f32x16& p1, float& m_reg, float& mn, float& alpha) {
  constexpr float SCALE = Cfg<MLA>::SCALE, C = SCALE * 1.4426950408889634f;
  float pmax = p0[0]; for (int r = 1; r < 16; ++r) pmax = fmaxf(pmax, p0[r]); for (int r = 0; r < 16; ++r) pmax = fmaxf(pmax, p1[r]);
  { auto rr = __builtin_amdgcn_permlane32_swap(__float_as_uint(pmax), __float_as_uint(pmax), false, false);
    pmax = fmaxf(__uint_as_float(rr[0]), __uint_as_float(rr[1])); }
  if (__builtin_expect(__all(pmax - m_reg <= THR / SCALE), 1)) { mn = m_reg; alpha = 1.f; }
  else { mn = fmaxf(m_reg, pmax); alpha = __builtin_amdgcn_exp2f((m_reg - mn) * C); m_reg = mn; }
  float mnC = -mn * C;
  for (int r = 0; r < 16; ++r) p0[r] = fmaf(p0[r], C, mnC); for (int r = 0; r < 16; ++r) p1[r] = fmaf(p1[r], C, mnC);
  for (int r = 0; r < 16; ++r) p0[r] = __builtin_amdgcn_exp2f(p0[r]);
}
__device__ __forceinline__ void finishSM(f32x16& p0, f32x16& p1, float alpha, float& l_reg, bf16x8& pa0, bf16x8& pa1, bf16x8& pa2, bf16x8& pa3) {
  for (int r = 0; r < 16; ++r) p1[r] = __builtin_amdgcn_exp2f(p1[r]);
  float ps = 0; for (int r = 0; r < 16; ++r) ps += p0[r]; for (int r = 0; r < 16; ++r) ps += p1[r];
  { auto rr = __builtin_amdgcn_permlane32_swap(__float_as_uint(ps), __float_as_uint(ps), false, false);
    ps = __uint_as_float(rr[0]) + __uint_as_float(rr[1]); }
  l_reg = l_reg * alpha + ps;
#define PK4(P, BASE, OUT) do { unsigned a0 = cvtpk(P[BASE + 0], P[BASE + 1]), a1 = cvtpk(P[BASE + 2], P[BASE + 3]);   \
    unsigned b0 = cvtpk(P[BASE + 4], P[BASE + 5]), b1 = cvtpk(P[BASE + 6], P[BASE + 7]);                              \
    auto r0 = __builtin_amdgcn_permlane32_swap(a0, b0, false, false); auto r1 = __builtin_amdgcn_permlane32_swap(a1, b1, false, false); \
    u32x4 w = {r0[0], r1[0], r0[1], r1[1]}; OUT = *reinterpret_cast<bf16x8*>(&w); } while (0)
  PK4(p0, 0, pa0); PK4(p0, 8, pa1); PK4(p1, 0, pa2); PK4(p1, 8, pa3);
#undef PK4
}
template <bool MLA>
__device__ __forceinline__ void qkt(f32x16& p0, f32x16& p1, const char* Ks, const char* Krs, const bf16x8* qr, const char* qrl, int r32, int hi) {
  p0 = f32x16{}; p1 = f32x16{};
#pragma unroll
  for (int d0 = 0; d0 < 8; ++d0) { int cb = (d0 * 16 + hi * 8) * 2;
    bf16x8 b0 = *reinterpret_cast<const bf16x8*>(Ks + KSWZ(r32, cb));
    bf16x8 b1 = *reinterpret_cast<const bf16x8*>(Ks + KSWZ(32 + r32, cb));
    p0 = __builtin_amdgcn_mfma_f32_32x32x16_bf16(b0, qr[d0], p0, 0, 0, 0);
    p1 = __builtin_amdgcn_mfma_f32_32x32x16_bf16(b1, qr[d0], p1, 0, 0, 0); }
  if constexpr (MLA) {
#pragma unroll
    for (int d0 = 0; d0 < 4; ++d0) { int ch = d0 * 2 + hi;
      bf16x8 b0 = *reinterpret_cast<const bf16x8*>(Krs + KRSWZ(r32, ch));
      bf16x8 b1 = *reinterpret_cast<const bf16x8*>(Krs + KRSWZ(32 + r32, ch));
      const bf16x8 qf = *reinterpret_cast<const bf16x8*>(qrl + KRSWZ(r32, ch));
      p0 = __builtin_amdgcn_mfma_f32_32x32x16_bf16(b0, qf, p0, 0, 0, 0);
      p1 = __builtin_amdgcn_mfma_f32_32x32x16_bf16(b1, qf, p1, 0, 0, 0); }
  }
}
__device__ __forceinline__ int v_st(int k, int c) { const int kk = (k & ~0xC) | ((k & 4) << 1) | ((k & 8) >> 1); return ((kk >> 3) * 4 + (c >> 5)) * 512 + ((kk & 7) * 32 + (c & 31)) * 2; }
__device__ __forceinline__ int v_rd_base(int lane) { return ((lane & 3) << 3) | (((lane >> 2) & 3) << 6) | (((lane >> 4) & 1) << 5) | (((lane >> 5) & 1) << 8); }
constexpr int v_rd_off(int d0, int ks, int half) { return d0 * 512 + ks * 4096 + half * 2048; }
template <int OFF> __device__ __forceinline__ s16x4 tr_read(int vb) {
  s16x4 r; asm volatile("ds_read_b64_tr_b16 %0, %1 offset:%2" : "=&v"(r) : "v"(vb), "i"(OFF) : "memory"); return r;
}
template <int D0> __device__ __forceinline__ void pv_one(f32x16& od, int vb, bf16x8 pa0, bf16x8 pa1, bf16x8 pa2, bf16x8 pa3) {
  const s16x4 l0 = tr_read<v_rd_off(D0, 0, 0)>(vb), h0 = tr_read<v_rd_off(D0, 0, 1)>(vb), l1 = tr_read<v_rd_off(D0, 1, 0)>(vb), h1 = tr_read<v_rd_off(D0, 1, 1)>(vb);
  const s16x4 l2 = tr_read<v_rd_off(D0, 2, 0)>(vb), h2 = tr_read<v_rd_off(D0, 2, 1)>(vb), l3 = tr_read<v_rd_off(D0, 3, 0)>(vb), h3 = tr_read<v_rd_off(D0, 3, 1)>(vb);
  asm volatile("s_waitcnt lgkmcnt(0)" ::: "memory"); SBAR();
#define PK(L, H) (bf16x8){L[0], L[1], L[2], L[3], H[0], H[1], H[2], H[3]}
  od = __builtin_amdgcn_mfma_f32_32x32x16_bf16(pa0, PK(l0, h0), od, 0, 0, 0);
  od = __builtin_amdgcn_mfma_f32_32x32x16_bf16(pa1, PK(l1, h1), od, 0, 0, 0);
  od = __builtin_amdgcn_mfma_f32_32x32x16_bf16(pa2, PK(l2, h2), od, 0, 0, 0);
  od = __builtin_amdgcn_mfma_f32_32x32x16_bf16(pa3, PK(l3, h3), od, 0, 0, 0);
#undef PK
}
__device__ __forceinline__ void pv_d0(f32x16* o, int vb, bf16x8 pa0, bf16x8 pa1, bf16x8 pa2, bf16x8 pa3) {
  pv_one<0>(o[0], vb, pa0, pa1, pa2, pa3); pv_one<1>(o[1], vb, pa0, pa1, pa2, pa3); pv_one<2>(o[2], vb, pa0, pa1, pa2, pa3); pv_one<3>(o[3], vb, pa0, pa1, pa2, pa3);
}
template <bool MLA, int LDQ, int LDK, int LDO>
__device__ __forceinline__ void attn_unit(const bf16* __restrict__ Qb, const bf16* __restrict__ Kh, const bf16* __restrict__ Krh, const bf16* __restrict__ Vh,
                                          bf16* __restrict__ Ob, int seq, char* lds) {
  constexpr int NQ = Cfg<MLA>::NQ;
  const int tid = mytid(), wid = tid >> 6, lane = tid & 63, r32 = lane & 31, hi = lane >> 5;
  char* V_lds = lds + OFF_V; char* K_lds = lds + OFF_K; char* KR_lds = lds + OFF_KR;
  float* ws = (float*)(lds + OFF_WS) + wid * 64; float* li_l = ws; float* al_l = ws + 32;
  float m_reg = -1e30f, l_reg = 0; f32x16 o[4] = {}; bf16x8 qr[NQ];
  const bf16* Qw = Qb + (long)(wid * QBLK + r32) * LDQ + hi * 8;
#pragma unroll
  for (int d0 = 0; d0 < NQ; ++d0) qr[d0] = ld8(Qw + d0 * 16);
  char* qrl = lds + OFF_QR + wid * 4096;
  if constexpr (MLA) {
#pragma unroll
    for (int d0 = 0; d0 < 4; ++d0) *reinterpret_cast<bf16x8*>(qrl + KRSWZ(r32, d0 * 2 + hi)) = ld8(Qw + 128 + d0 * 16);
  }
  const int sr = tid >> 4, sc = (tid & 15) * 8, vst0 = v_st(sr, sc), vst1 = v_st(32 + sr, sc);
  const int krr = tid >> 3, krc = tid & 7, krst = KRSWZ(krr, krc);
  const int vb0 = (int)(uintptr_t)V_lds + v_rd_base(lane);
  constexpr int SDEPTH = MLA ? 1 : 2;
  struct { bf16x8 vs0, vs1, ks0, ks1, kr; } sr_[SDEPTH];
#define SLOAD(i, k0) do { sr_[i].vs0 = ld8(&Vh[(long)((k0) + sr) * LDK + sc]); sr_[i].vs1 = ld8(&Vh[(long)((k0) + 32 + sr) * LDK + sc]); \
    sr_[i].ks0 = ld8(&Kh[(long)((k0) + sr) * LDK + sc]); sr_[i].ks1 = ld8(&Kh[(long)((k0) + 32 + sr) * LDK + sc]); \
    if constexpr (MLA) sr_[i].kr = ld8(&Krh[(long)((k0) + krr) * 64 + krc * 8]); } while (0)
#define SWRITE(b, i) do { *(bf16x8*)(V_lds + (b) * SHM_V + vst0) = sr_[i].vs0;          \
    *(bf16x8*)(V_lds + (b) * SHM_V + vst1) = sr_[i].vs1; int kc = sc * 2;               \
    *(bf16x8*)(K_lds + (b) * SHM_K + KSWZ(sr, kc)) = sr_[i].ks0;                       \
    *(bf16x8*)(K_lds + (b) * SHM_K + KSWZ(32 + sr, kc)) = sr_[i].ks1;                  \
    if constexpr (MLA) *(bf16x8*)(KR_lds + (b) * SHM_KR + krst) = sr_[i].kr; } while (0)
#define SWAIT() do { if constexpr (SDEPTH == 2) asm volatile("s_waitcnt vmcnt(4)" ::: "memory"); else asm volatile("s_waitcnt vmcnt(0)" ::: "memory"); } while (0)
#define RESC(a) do { if (__any((a) < 1.f)) { if (hi == 0) al_l[r32] = (a); asm volatile("s_waitcnt lgkmcnt(0)" ::: "memory"); \
    for (int d = 0; d < 4; ++d) for (int r = 0; r < 16; ++r) o[d][r] *= al_l[crow(r, hi)]; } } while (0)
  f32x16 pA0, pA1, pB0, pB1; float mnA, mnB, alA, alB; bf16x8 pa0, pa1, pa2, pa3; const int NT = seq / KVBLK;
  constexpr int SE = 0, SO = SDEPTH - 1;
  SLOAD(SE, 0); asm volatile("s_waitcnt vmcnt(0)" ::: "memory"); SWRITE(0, SE); __syncthreads();
  qkt<MLA>(pA0, pA1, K_lds, KR_lds, qr, qrl, r32, hi); partialSM<MLA>(pA0, pA1, m_reg, mnA, alA);
  SLOAD(SO, KVBLK); if constexpr (SDEPTH == 2) { if (2 < NT) SLOAD(SE, 2 * KVBLK); }
  SWAIT(); SWRITE(1, SO); __syncthreads();
  for (int j = 1; j + 1 < NT; j += 2) {
    SBAR(); qkt<MLA>(pB0, pB1, K_lds + SHM_K, KR_lds + SHM_KR, qr, qrl, r32, hi);
    finishSM(pA0, pA1, alA, l_reg, pa0, pa1, pa2, pa3); SBAR();
    SLOAD(SO, (j + SDEPTH) * KVBLK); SBAR();
    pv_d0(o, vb0, pa0, pa1, pa2, pa3); partialSM<MLA>(pB0, pB1, m_reg, mnB, alB);
    __syncthreads(); SWAIT(); SWRITE(0, SE);
    RESC(alB); __syncthreads();
    SBAR(); qkt<MLA>(pA0, pA1, K_lds, KR_lds, qr, qrl, r32, hi);
    finishSM(pB0, pB1, alB, l_reg, pa0, pa1, pa2, pa3); SBAR();
    if (SDEPTH == 1 || j + 3 < NT) SLOAD(SE, (j + 1 + SDEPTH) * KVBLK); SBAR();
    pv_d0(o, vb0 + (int)SHM_V, pa0, pa1, pa2, pa3); partialSM<MLA>(pA0, pA1, m_reg, mnA, alA);
    __syncthreads(); SWAIT(); SWRITE(1, SO);
    RESC(alA); __syncthreads();
  }
  SBAR(); qkt<MLA>(pB0, pB1, K_lds + SHM_K, KR_lds + SHM_KR, qr, qrl, r32, hi);
  finishSM(pA0, pA1, alA, l_reg, pa0, pa1, pa2, pa3); SBAR();
  pv_d0(o, vb0, pa0, pa1, pa2, pa3); partialSM<MLA>(pB0, pB1, m_reg, mnB, alB);
  __syncthreads(); RESC(alB);
  finishSM(pB0, pB1, alB, l_reg, pa0, pa1, pa2, pa3); SBAR();
  pv_d0(o, vb0 + (int)SHM_V, pa0, pa1, pa2, pa3);
  if (hi == 0) li_l[r32] = l_reg; asm volatile("s_waitcnt lgkmcnt(0)" ::: "memory");
  float rli[16];
#pragma unroll
  for (int r = 0; r < 16; ++r) rli[r] = __builtin_amdgcn_rcpf(li_l[crow(r, hi)]);
  bf16* Ow = Ob + (long)(wid * QBLK) * LDO;
#pragma unroll
  for (int r = 0; r < 16; ++r) { int orow = crow(r, hi);
#pragma unroll
    for (int d0 = 0; d0 < 4; ++d0) Ow[(long)orow * LDO + d0 * 32 + r32] = __float2bfloat16(o[d0][r] * rli[r]); }
  __syncthreads();
#undef SLOAD
#undef SWRITE
#undef SWAIT
#undef RESC
}

template <bool MLA, int LDQ, int LDK, int LDO>
__device__ __forceinline__ void attn_unit_simple(const bf16* __restrict__ Qb, const bf16* __restrict__ Kh, const bf16* __restrict__ Krh, const bf16* __restrict__ Vh,
                                                 bf16* __restrict__ Ob, int seq, char* lds) {
  const int tid = mytid(), wid = tid >> 6, lane = tid & 63, r32 = lane & 31, hi = lane >> 5;
  char* V_lds = lds + OFF_V; char* K_lds = lds + OFF_K; char* KR_lds = lds + OFF_KR;
  float* ws = (float*)(lds + OFF_WS) + wid * 64; float* li_l = ws; float* al_l = ws + 32;
  float m_reg = -1e30f, l_reg = 0; f32x16 o[4] = {}; bf16x8 qr[8];
  const bf16* Qw = Qb + (long)(wid * QBLK + r32) * LDQ + hi * 8;
#pragma unroll
  for (int d0 = 0; d0 < 8; ++d0) qr[d0] = ld8(Qw + d0 * 16);
  char* qrl = lds + OFF_QR + wid * 4096;
  if constexpr (MLA) {
#pragma unroll
    for (int d0 = 0; d0 < 4; ++d0) *reinterpret_cast<bf16x8*>(qrl + KRSWZ(r32, d0 * 2 + hi)) = ld8(Qw + 128 + d0 * 16);
  }
  const int sr = tid >> 4, sc = (tid & 15) * 8, vst0 = v_st(sr, sc), vst1 = v_st(32 + sr, sc);
  const int krr = tid >> 3, krc = tid & 7, krst = KRSWZ(krr, krc);
  const int vb0 = (int)(uintptr_t)V_lds + v_rd_base(lane);
  bf16x8 vs0, vs1, ks0, ks1, krs;
#define SLOAD(k0) do { vs0 = ld8(&Vh[(long)((k0) + sr) * LDK + sc]); vs1 = ld8(&Vh[(long)((k0) + 32 + sr) * LDK + sc]); \
    ks0 = ld8(&Kh[(long)((k0) + sr) * LDK + sc]); ks1 = ld8(&Kh[(long)((k0) + 32 + sr) * LDK + sc]); \
    if constexpr (MLA) krs = ld8(&Krh[(long)((k0) + krr) * 64 + krc * 8]); } while (0)
#define SWRITE(b) do { *(bf16x8*)(V_lds + (b) * SHM_V + vst0) = vs0; *(bf16x8*)(V_lds + (b) * SHM_V + vst1) = vs1; int kc = sc * 2; \
    *(bf16x8*)(K_lds + (b) * SHM_K + KSWZ(sr, kc)) = ks0; *(bf16x8*)(K_lds + (b) * SHM_K + KSWZ(32 + sr, kc)) = ks1; \
    if constexpr (MLA) *(bf16x8*)(KR_lds + (b) * SHM_KR + krst) = krs; } while (0)
  const int NT = seq / KVBLK;
  SLOAD(0); SWRITE(0); __syncthreads();
#pragma unroll 1
  for (int j = 0; j < NT; ++j) {
    const int b = j & 1;
    if (j + 1 < NT) SLOAD((j + 1) * KVBLK);
    f32x16 p0, p1; float mn, al; bf16x8 pa0, pa1, pa2, pa3;
    SBAR(); qkt<MLA>(p0, p1, K_lds + b * SHM_K, KR_lds + b * SHM_KR, qr, qrl, r32, hi);
    partialSM<MLA>(p0, p1, m_reg, mn, al);
    if (__any(al < 1.f)) { if (hi == 0) al_l[r32] = al; asm volatile("s_waitcnt lgkmcnt(0)" ::: "memory");
#pragma unroll
      for (int d = 0; d < 4; ++d)
#pragma unroll
        for (int r = 0; r < 16; ++r) o[d][r] *= al_l[crow(r, hi)]; }
    finishSM(p0, p1, al, l_reg, pa0, pa1, pa2, pa3); SBAR();
    pv_d0(o, vb0 + b * (int)SHM_V, pa0, pa1, pa2, pa3);
    if (j + 1 < NT) SWRITE(b ^ 1);
    __syncthreads();
  }
  if (hi == 0) li_l[r32] = l_reg; asm volatile("s_waitcnt lgkmcnt(0)" ::: "memory");
  float rli[16];
#pragma unroll
  for (int r = 0; r < 16; ++r) rli[r] = __builtin_amdgcn_rcpf(li_l[crow(r, hi)]);
  bf16* Ow = Ob + (long)(wid * QBLK) * LDO;
#pragma unroll
  for (int r = 0; r < 16; ++r) { int orow = crow(r, hi);
#pragma unroll
    for (int d0 = 0; d0 < 4; ++d0) Ow[(long)orow * LDO + d0 * 32 + r32] = __float2bfloat16(o[d0][r] * rli[r]); }
  __syncthreads();
#undef SLOAD
#undef SWRITE
}
#undef KSWZ
#undef KRSWZ
#undef SBAR
}
namespace fx {
typedef unsigned short bf16_t;
typedef short bf16x8 __attribute__((ext_vector_type(8)));
typedef float f32x4 __attribute__((ext_vector_type(4)));
typedef unsigned u32x4 __attribute__((ext_vector_type(4)));
typedef unsigned u32x2 __attribute__((ext_vector_type(2)));
__device__ __forceinline__ unsigned cvtpk(float lo, float hi) { return cvtpk_safe(lo, hi); }
__device__ __forceinline__ float bf2f(unsigned short h) { return __uint_as_float(((unsigned)h) << 16); }
constexpr int LD128 = 136 * 2, LD256 = 264 * 2;
constexpr int R0 = 0, R1 = 256 * LD128;
__device__ __forceinline__ void g2l(char* lds, int ldb, const bf16_t* g, size_t gld, int rows, int cols) {
    const int cpr = cols >> 3, n = rows * cpr;
    for (int i = mytid(); i < n; i += 512) { const int r = i / cpr, ch = i - r * cpr;
        *(u32x4*)(lds + r * ldb + ch * 16) = *(const u32x4*)(g + (size_t)r * gld + ch * 8); }
}
__device__ __forceinline__ void f1_item(char* lds, const bf16_t* PA, const bf16_t* DA, const bf16_t* CS, bf16_t* T, int tok0, int tstride, int g, int n2, int N2, int Ltot, int seqg) {
    const int tid = mytid(), w = tid >> 6, lane = tid & 63, fr = lane & 15, fq = lane >> 4;
    for (int i = tid; i < 128 * 16; i += 512) { const int r = i >> 4, ch = i & 15;
        *(u32x4*)(lds + R0 + r * LD128 + ch * 16) = *(const u32x4*)(PA + (size_t)(tok0 + r * tstride) * 512 + g * 128 + ch * 8); }
    g2l(lds + R1, LD128, DA, 128, 256, 128);
    __builtin_amdgcn_sched_barrier(0); __syncthreads(); __builtin_amdgcn_sched_barrier(0);
    f32x4 acc[8][2];
#pragma unroll
    for (int rt = 0; rt < 8; ++rt) { acc[rt][0] = (f32x4){0.f, 0.f, 0.f, 0.f}; acc[rt][1] = (f32x4){0.f, 0.f, 0.f, 0.f}; }
#pragma unroll
    for (int ks = 0; ks < 4; ++ks) {
        bf16x8 b[2], a[8];
#pragma unroll
        for (int ct = 0; ct < 2; ++ct) b[ct] = *(const bf16x8*)(lds + R1 + (32 * w + 16 * ct + fr) * LD128 + (32 * ks + 8 * fq) * 2);
#pragma unroll
        for (int rt = 0; rt < 8; ++rt) a[rt] = *(const bf16x8*)(lds + R0 + (16 * rt + fr) * LD128 + (32 * ks + 8 * fq) * 2);
#pragma unroll
        for (int rt = 0; rt < 8; ++rt)
#pragma unroll
            for (int ct = 0; ct < 2; ++ct) acc[rt][ct] = __builtin_amdgcn_mfma_f32_16x16x32_bf16(a[rt], b[ct], acc[rt][ct], 0, 0, 0);
    }
    __builtin_amdgcn_sched_barrier(0); __syncthreads(); __builtin_amdgcn_sched_barrier(0);
#pragma unroll
    for (int rt = 0; rt < 8; ++rt)
#pragma unroll
        for (int ct = 0; ct < 2; ++ct) { u32x2 v; v.x = cvtpk(acc[rt][ct][0], acc[rt][ct][1]); v.y = cvtpk(acc[rt][ct][2], acc[rt][ct][3]);
            *(u32x2*)(lds + R0 + (32 * w + 16 * ct + fr) * LD128 + (16 * rt + 4 * fq) * 2) = v; }
    g2l(lds + R1, LD256, CS, 256, 128, 256);
    __builtin_amdgcn_sched_barrier(0); __syncthreads(); __builtin_amdgcn_sched_barrier(0);
    f32x4 ar[8], ai[8];
#pragma unroll
    for (int rt = 0; rt < 8; ++rt) { ar[rt] = (f32x4){0.f, 0.f, 0.f, 0.f}; ai[rt] = (f32x4){0.f, 0.f, 0.f, 0.f}; }
#pragma unroll
    for (int ks = 0; ks < 8; ++ks) {
        const int part = ks >> 2, n1o = (32 * (ks & 3) + 8 * fq) * 2;
        const bf16x8 cfr = *(const bf16x8*)(lds + R1 + (16 * w + fr) * LD256 + n1o);
        const bf16x8 sfr = *(const bf16x8*)(lds + R1 + (16 * w + fr) * LD256 + 256 + n1o);
        bf16x8 nsfr;
#pragma unroll
        for (int i = 0; i < 8; ++i) nsfr[i] = (short)(sfr[i] ^ (short)0x8000);
        const bf16x8 br = part == 0 ? cfr : sfr, bi = part == 0 ? nsfr : cfr;
        bf16x8 a[8];
#pragma unroll
        for (int rt = 0; rt < 8; ++rt) a[rt] = *(const bf16x8*)(lds + R0 + (part * 128 + 16 * rt + fr) * LD128 + n1o);
#pragma unroll
        for (int rt = 0; rt < 8; ++rt) { ar[rt] = __builtin_amdgcn_mfma_f32_16x16x32_bf16(a[rt], br, ar[rt], 0, 0, 0); ai[rt] = __builtin_amdgcn_mfma_f32_16x16x32_bf16(a[rt], bi, ai[rt], 0, 0, 0); }
    }
    const int k1 = 16 * w + fr;
    const float frac = (float)((n2 * k1) % Ltot) / (float)Ltot;
    const float ct_ = __builtin_amdgcn_cosf(frac), st_ = __builtin_amdgcn_sinf(frac);
    bf16_t* Trow = T + ((size_t)(seqg * 128 + k1) * N2 + n2) * 256;
#pragma unroll
    for (int rt = 0; rt < 8; ++rt) { f32x4 tr, ti;
#pragma unroll
        for (int i = 0; i < 4; ++i) { tr[i] = ar[rt][i] * ct_ + ai[rt][i] * st_; ti[i] = ai[rt][i] * ct_ - ar[rt][i] * st_; }
        u32x2 v; v.x = cvtpk(tr[0], tr[1]); v.y = cvtpk(tr[2], tr[3]); *(u32x2*)(Trow + 16 * rt + 4 * fq) = v;
        v.x = cvtpk(ti[0], ti[1]); v.y = cvtpk(ti[2], ti[3]); *(u32x2*)(Trow + 128 + 16 * rt + 4 * fq) = v; }
    __builtin_amdgcn_sched_barrier(0); __syncthreads(); __builtin_amdgcn_sched_barrier(0);
}
__device__ __forceinline__ void f2_item(char* lds, const bf16_t* T, const bf16_t* W2, bf16_t* MIX, int seqg, int k1, bool load_w2) {
    const int tid = mytid(), w = tid >> 6, lane = tid & 63, fr = lane & 15, fq = lane >> 4;
    const bf16_t* slab = T + (size_t)(seqg * 128 + k1) * 64 * 256;
    for (int i = tid; i < 64 * 32; i += 512) { const int row = i >> 5, ch = i & 31, part = ch >> 4, m0 = (ch & 15) * 8;
        const bf16x8 v = *(const bf16x8*)(slab + (size_t)row * 256 + ch * 8);
#pragma unroll
        for (int j = 0; j < 8; ++j) *(short*)(lds + R0 + (m0 + j) * LD128 + (part * 64 + row) * 2) = v[j]; }
    if (load_w2) g2l(lds + R1, LD128, W2, 128, 64, 128);
    __builtin_amdgcn_sched_barrier(0); __syncthreads(); __builtin_amdgcn_sched_barrier(0);
    f32x4 acc[4];
#pragma unroll
    for (int ct = 0; ct < 4; ++ct) acc[ct] = (f32x4){0.f, 0.f, 0.f, 0.f};
#pragma unroll
    for (int ks = 0; ks < 4; ++ks) {
        const bf16x8 a = *(const bf16x8*)(lds + R0 + (16 * w + fr) * LD128 + (32 * ks + 8 * fq) * 2);
#pragma unroll
        for (int ct = 0; ct < 4; ++ct) { const bf16x8 b = *(const bf16x8*)(lds + R1 + (16 * ct + fr) * LD128 + (32 * ks + 8 * fq) * 2);
            acc[ct] = __builtin_amdgcn_mfma_f32_16x16x32_bf16(a, b, acc[ct], 0, 0, 0); }
    }
    const int b = seqg >> 2, g = seqg & 3;
#pragma unroll
    for (int ct = 0; ct < 4; ++ct) { const int k2 = 16 * ct + fr; u32x2 v; v.x = cvtpk(acc[ct][0], acc[ct][1]); v.y = cvtpk(acc[ct][2], acc[ct][3]);
        *(u32x2*)(MIX + (size_t)(b * 8192 + k1 + 128 * k2) * 1024 + g * 128 + 16 * w + 4 * fq) = v; }
    __builtin_amdgcn_sched_barrier(0); __syncthreads(); __builtin_amdgcn_sched_barrier(0);
}
__device__ __forceinline__ void conv_item(char* lds, const bf16_t* U, const float* cw, const float* cb, const float* cg, bf16_t* MIX, int t0, int s0, int s1) {
    const int tid = mytid(), w = tid >> 6, lane = tid & 63;
    for (int i = tid; i < 62 * 64; i += 512) { const int r = i >> 6, ch = i & 63, tok = t0 - 15 + r;
        u32x4 v = (u32x4){0u, 0u, 0u, 0u}; if (tok >= s0 && tok < s1) v = *(const u32x4*)(U + (size_t)tok * 512 + ch * 8);
        *(u32x4*)(lds + R0 + r * 1024 + ch * 16) = v; }
    for (int i = tid; i < 31 * 128; i += 512) *(f32x4*)(lds + R1 + i * 16) = *(const f32x4*)(cw + i * 4);
    __builtin_amdgcn_sched_barrier(0); __syncthreads(); __builtin_amdgcn_sched_barrier(0);
    const int c0 = lane * 8;
    f32x4 bias0 = *(const f32x4*)(cb + c0), bias1 = *(const f32x4*)(cb + c0 + 4), g0 = *(const f32x4*)(cg + c0), g1 = *(const f32x4*)(cg + c0 + 4);
#pragma unroll 1
    for (int tt = 0; tt < 4; ++tt) { const int t = 4 * w + tt;
        f32x4 a0 = bias0, a1 = bias1;
#pragma unroll 2
        for (int j = 0; j < 31; ++j) { const bf16x8 uv = *(const bf16x8*)(lds + R0 + (t + j) * 1024 + c0 * 2);
            const f32x4 w0 = *(const f32x4*)(lds + R1 + (j * 512 + c0) * 4), w1 = *(const f32x4*)(lds + R1 + (j * 512 + c0 + 4) * 4);
            a0[0] += bf2f((unsigned short)uv[0]) * w0[0]; a0[1] += bf2f((unsigned short)uv[1]) * w0[1]; a0[2] += bf2f((unsigned short)uv[2]) * w0[2]; a0[3] += bf2f((unsigned short)uv[3]) * w0[3];
            a1[0] += bf2f((unsigned short)uv[4]) * w1[0]; a1[1] += bf2f((unsigned short)uv[5]) * w1[1]; a1[2] += bf2f((unsigned short)uv[6]) * w1[2]; a1[3] += bf2f((unsigned short)uv[7]) * w1[3]; }
        float ss = (a0[0] * a0[0] + a0[1] * a0[1]) + (a0[2] * a0[2] + a0[3] * a0[3]) + (a1[0] * a1[0] + a1[1] * a1[1]) + (a1[2] * a1[2] + a1[3] * a1[3]);
#pragma unroll
        for (int o = 1; o < 64; o <<= 1) ss += shx(ss, lane, o);
        const float rstd = rsqrtf(ss * (1.0f / 512.0f) + 1e-6f);
        f32x4 y0 = a0 * rstd * g0, y1 = a1 * rstd * g1;
#pragma unroll
        for (int i = 0; i < 4; ++i) { y0[i] = y0[i] * __builtin_amdgcn_rcpf(1.0f + __expf(-y0[i])); y1[i] = y1[i] * __builtin_amdgcn_rcpf(1.0f + __expf(-y1[i])); }
        u32x4 o4; o4.x = cvtpk(y0[0], y0[1]); o4.y = cvtpk(y0[2], y0[3]); o4.z = cvtpk(y1[0], y1[1]); o4.w = cvtpk(y1[2], y1[3]);
        *(u32x4*)(MIX + (size_t)(t0 + t) * 1024 + 512 + c0) = o4; }
    __builtin_amdgcn_sched_barrier(0); __syncthreads(); __builtin_amdgcn_sched_barrier(0);
}
}
constexpr int DM = 1024, SEQ = 8192, CTXL = 256, NLAT = 2 * SEQ, NROWS = NLAT + 2 * CTXL;
constexpr int KEYS = SEQ + CTXL;
constexpr int NEXP = 32, MAXTILES = 168, XGROWS = MAXTILES * 256;
constexpr float EPS = 1e-6f;
constexpr size_t al256(size_t x) { return (x + 255) / 256 * 256; }
constexpr size_t WS_CTL = 0;
constexpr size_t WS_MODV = 65536;
constexpr size_t WS_COSC = al256(WS_MODV + 4 * 3 * 6144 * 4);
constexpr size_t WS_SINC = WS_COSC + 8192 * 64 * 4;
constexpr size_t WS_COSD = WS_SINC + 8192 * 64 * 4;
constexpr size_t WS_SIND = WS_COSD + 8192 * 32 * 4;
constexpr size_t WS_DA = WS_SIND + 8192 * 32 * 4;
constexpr size_t WS_CS = WS_DA + 256 * 128 * 2;
constexpr size_t WS_W2 = WS_CS + 128 * 256 * 2;
constexpr size_t WS_RWT = WS_W2 + 64 * 128 * 2;
constexpr size_t WS_WINAB = al256(WS_RWT + 4 * 36 * 1024 * 4);
constexpr size_t WS_WOUTAB = WS_WINAB + (size_t)2 * 1536 * 1024 * 2;
constexpr size_t WS_WINCD = WS_WOUTAB + (size_t)2 * 1024 * 1024 * 2;
constexpr size_t WS_WUQ = WS_WINCD + (size_t)2 * 1792 * 1024 * 2;
constexpr size_t WS_WUKV = WS_WUQ + (size_t)2 * 768 * 384 * 2;
constexpr size_t WS_WOUTCD = WS_WUKV + (size_t)2 * 1024 * 256 * 2;
constexpr size_t WS_WGU = WS_WOUTCD + (size_t)2 * 1024 * 1024 * 2;
constexpr size_t WS_WD = WS_WGU + (size_t)4 * 32 * 1024 * 1024 * 2;
constexpr size_t WS_X = WS_WD + (size_t)4 * 32 * 1024 * 512 * 2;
constexpr size_t WS_H = WS_X + (size_t)NROWS * 1024 * 4;
constexpr size_t WS_MIX = WS_H + (size_t)NROWS * 1024 * 2;
constexpr size_t WS_P = WS_MIX + (size_t)NROWS * 1024 * 2;
constexpr size_t WS_T = WS_P + (size_t)NROWS * 1792 * 2;
constexpr size_t WS_TC = WS_T + (size_t)8 * 128 * 64 * 256 * 2;
constexpr size_t WS_ODD = WS_T;
constexpr size_t WS_QC = WS_ODD;
constexpr size_t WS_KC = WS_QC + (size_t)NROWS * 512 * 2;
constexpr size_t WS_VC = WS_KC + (size_t)2 * KEYS * 256 * 2;
constexpr size_t WS_CQ = WS_VC + (size_t)2 * KEYS * 256 * 2;
constexpr size_t WS_CKV = WS_CQ + (size_t)NROWS * 384 * 2;
constexpr size_t WS_KDR = WS_CKV + (size_t)NROWS * 256 * 2;
constexpr size_t WS_QD = WS_KDR + (size_t)2 * KEYS * 64 * 2;
constexpr size_t WS_KDN = WS_QD + (size_t)NROWS * 768 * 2;
constexpr size_t WS_VD = WS_KDN + (size_t)2 * KEYS * 512 * 2;
constexpr size_t WS_ODD_END = WS_VD + (size_t)2 * KEYS * 512 * 2;
constexpr size_t WS_EVEN_END = WS_TC + (size_t)8 * 128 * 2 * 256 * 2;
constexpr size_t WS_RES = al256(WS_ODD_END > WS_EVEN_END ? WS_ODD_END : WS_EVEN_END);
constexpr size_t WS_RW = WS_RES + (size_t)NROWS * 2 * 4;
constexpr size_t WS_XG = al256(WS_RW + (size_t)NROWS * 2 * 4);
constexpr size_t WS_HID = WS_XG + (size_t)XGROWS * 1024 * 2;
constexpr size_t WS_Y = WS_HID + (size_t)XGROWS * 512 * 2;
constexpr size_t WS_END = WS_Y + (size_t)XGROWS * 1024 * 2;
constexpr int LDS_BYTES = 147456, MISC_OFF = 139264;
typedef unsigned short bf16_t;
typedef float f32x4 __attribute__((ext_vector_type(4)));
typedef unsigned u32x4 __attribute__((ext_vector_type(4)));
typedef unsigned u32x2 __attribute__((ext_vector_type(2)));
typedef short bf16x8 __attribute__((ext_vector_type(8)));

struct Args { const float* in[29]; float* out; unsigned char* ws; int ph_lo, ph_hi; };
typedef const __attribute__((address_space(4))) Args* KArgs;
__device__ __forceinline__ KArgs kargs() { KArgs p = (KArgs)__builtin_amdgcn_kernarg_segment_ptr(); asm volatile("" : "+s"(p)); return p; }

__device__ __forceinline__ float wave_sum(float v, int lane) {
#pragma unroll
    for (int o = 1; o < 64; o <<= 1) v += shx(v, lane, o);
    return v;
}
__device__ __forceinline__ unsigned pk2(float lo, float hi) { return cvtpk_safe(lo, hi); }
__device__ __forceinline__ float bf_lo(unsigned w) { return __uint_as_float(w << 16); }
__device__ __forceinline__ float bf_hi(unsigned w) { return __uint_as_float(w & 0xffff0000u); }
__device__ __forceinline__ int cls_of(int r) { return r < SEQ ? 0 : (r < NLAT ? 1 : 2); }
__device__ __forceinline__ void compute_tstart(int* tstart, const int* cnt) {
    const int tid_ = mytid(); if (tid_ < 64) { const int lane = tid_; int c = lane < 32 ? cnt[lane] : 0; int nt = (c + 255) >> 8, s = nt;
#pragma unroll
        for (int o = 1; o < 32; o <<= 1) { int t = shup_i(s, lane, o); if (lane >= o) s += t; }
        if (lane < 32) tstart[lane] = s - nt; if (lane == 31) tstart[32] = s; }
    __syncthreads();
}
__device__ __forceinline__ void load_row(const float* p, int lane, f32x4 (&v)[4]) {
#pragma unroll
    for (int j = 0; j < 4; ++j) v[j] = *(const f32x4*)(p + 4 * lane + 256 * j);
}
__device__ __forceinline__ void moe_combine(f32x4 (&v)[4], int r, int lane, const int* res, const float* rwt, const bf16_t* Y, const int* tstart, const float* g2) {
    const int es0 = res[2 * r], es1 = res[2 * r + 1]; const float w0 = rwt[2 * r], w1 = rwt[2 * r + 1];
    const size_t row0 = (size_t)tstart[es0 >> 20] * 256 + (es0 & 0xfffff), row1 = (size_t)tstart[es1 >> 20] * 256 + (es1 & 0xfffff);
#pragma unroll
    for (int j = 0; j < 4; ++j) { const u32x2 a = *(const u32x2*)(Y + row0 * 1024 + 4 * lane + 256 * j), b = *(const u32x2*)(Y + row1 * 1024 + 4 * lane + 256 * j);
        const f32x4 g = *(const f32x4*)(g2 + 4 * lane + 256 * j);
        v[j][0] += g[0] * (w0 * bf_lo(a.x) + w1 * bf_lo(b.x)); v[j][1] += g[1] * (w0 * bf_hi(a.x) + w1 * bf_hi(b.x));
        v[j][2] += g[2] * (w0 * bf_lo(a.y) + w1 * bf_lo(b.y)); v[j][3] += g[3] * (w0 * bf_hi(a.y) + w1 * bf_hi(b.y)); }
}
__device__ __forceinline__ float row_rstd(const f32x4 (&v)[4], int lane) {
    float s = 0.f;
#pragma unroll
    for (int j = 0; j < 4; ++j) s += (v[j][0] * v[j][0] + v[j][1] * v[j][1]) + (v[j][2] * v[j][2] + v[j][3] * v[j][3]);
    return rsqrtf(wave_sum(s, lane) * (1.0f / 1024.0f) + EPS);
}
__device__ __forceinline__ void modulate(const f32x4 (&v)[4], float rstd, int lane, const float* g, const float* sc, const float* sh, f32x4 (&h)[4]) {
#pragma unroll
    for (int j = 0; j < 4; ++j) { const f32x4 gg = *(const f32x4*)(g + 4 * lane + 256 * j), s = *(const f32x4*)(sc + 4 * lane + 256 * j), b = *(const f32x4*)(sh + 4 * lane + 256 * j);
        h[j] = v[j] * rstd * gg * (1.0f + s) + b; }
}
__device__ __forceinline__ void store_row_bf16(bf16_t* p, int lane, const f32x4 (&h)[4]) {
#pragma unroll
    for (int j = 0; j < 4; ++j) { u32x2 o; o.x = pk2(h[j][0], h[j][1]); o.y = pk2(h[j][2], h[j][3]); *(u32x2*)(p + 4 * lane + 256 * j) = o; }
}
#define LAS __attribute__((address_space(3)))
#define XB_TMO      128
#define XB_XCNT(j)  (256  + 64 * (j))
#define XB_XSUB(j)  (1280 + 64 * (j))
#define XB_XGEN(j)  (2304 + 64 * (j))
#define XB_TOP      3328
#define XB_TOPGEN   3392
#define XCD_BAR_WORDS 3456
#define XB_SPIN_CAP (1u << 18)

__device__ __forceinline__ unsigned xb_ld(unsigned* p)              { return __hip_atomic_load(p, __ATOMIC_RELAXED, __HIP_MEMORY_SCOPE_AGENT); }
__device__ __forceinline__ unsigned xb_add(unsigned* p, unsigned v) { return __hip_atomic_fetch_add(p, v, __ATOMIC_RELAXED, __HIP_MEMORY_SCOPE_AGENT); }
__device__ __forceinline__ unsigned xb_xcc_id() { return (unsigned)__builtin_amdgcn_s_getreg((3 << 11) | 20) & 0xFu; }
#define XB_SPIN(cond, bar) do { unsigned _sp = 0; while (cond) { __builtin_amdgcn_s_sleep(1); \
    if ((++_sp & 255u) == 0u) { if (xb_ld(&(bar)[XB_TMO])) break; if (_sp > XB_SPIN_CAP) { atomicAdd(&(bar)[XB_TMO], 1u); break; } } } } while (0)

struct XcdBarrier {
    unsigned* bar; unsigned x;
    volatile LAS unsigned* st;
};

__device__ __forceinline__ XcdBarrier xcd_barrier_post(unsigned* bar, volatile LAS unsigned* st) {
    XcdBarrier b; b.bar = bar; b.x = xb_xcc_id(); b.st = st;
    if (threadIdx.x == 0) (void)xb_add(&bar[XB_XCNT(b.x)], 1u);
    return b;
}
__device__ __forceinline__ void xcd_barrier_complete(unsigned* bar, unsigned x, unsigned& nloc, unsigned& nx) {
    const unsigned G = gridDim.x * gridDim.y * gridDim.z;
    unsigned sum, cnt, mine, sp = 0u;
    for (;;) {
        sum = 0u; cnt = 0u; mine = 0u;
#pragma unroll
        for (unsigned j = 0; j < 16; ++j) { const unsigned c = xb_ld(&bar[XB_XCNT(j)]); sum += c; cnt += (c > 0u) ? 1u : 0u; mine = (j == x) ? c : mine; }
        if (sum == G) break;
        __builtin_amdgcn_s_sleep(1);
        if ((++sp & 255u) == 0u) { if (xb_ld(&bar[XB_TMO])) break; if (sp > XB_SPIN_CAP) { atomicAdd(&bar[XB_TMO], 1u); break; } }
    }
    nloc = mine > 0u ? mine : 1u; nx = cnt > 0u ? cnt : 1u;
}

__device__ __forceinline__ void xcd_barrier(const XcdBarrier& b) {
    asm volatile("s_waitcnt vmcnt(0)" ::: "memory");
    __syncthreads();
    if (threadIdx.x == 0) {
        unsigned* bar = b.bar;
        __builtin_amdgcn_s_waitcnt(0);
        unsigned nloc = b.st[0], nx = b.st[1];
        if (nloc == 0u) { xcd_barrier_complete(bar, b.x, nloc, nx); b.st[0] = nloc; b.st[1] = nx; }
        const unsigned old = xb_add(&bar[XB_XSUB(b.x)], 1u);
        const unsigned gen = old / nloc;
        if (old + 1u == (gen + 1u) * nloc) {
            __builtin_amdgcn_fence(__ATOMIC_RELEASE, "agent");
            asm volatile("s_waitcnt vmcnt(0)" ::: "memory");
            const unsigned og = xb_add(&bar[XB_TOP], 1u);
            const unsigned tg = og / nx;
            if (og + 1u == (tg + 1u) * nx) xb_add(&bar[XB_TOPGEN], 1u);
            else XB_SPIN(xb_ld(&bar[XB_TOPGEN]) == tg, bar);
            __builtin_amdgcn_fence(__ATOMIC_ACQUIRE, "agent");
            xb_add(&bar[XB_XGEN(b.x)], 1u);
            asm volatile("s_waitcnt vmcnt(0)" ::: "memory");
        } else {
            XB_SPIN(xb_ld(&bar[XB_XGEN(b.x)]) == gen, bar);
            __builtin_amdgcn_fence(__ATOMIC_ACQUIRE, "agent");
            asm volatile("s_waitcnt vmcnt(0)" ::: "memory");
        }
    }
    __syncthreads();
}

__device__ __forceinline__ void transpose_item(const float* W, int K, int N, bf16_t* WT, int k0, int n0, int drow0, float* scr, int lane) {
#pragma unroll 8
    for (int i = 0; i < 32; ++i) { const int kk = 2 * i + (lane >> 5); scr[kk * 33 + (lane & 31)] = W[(size_t)(k0 + kk) * N + n0 + (lane & 31)]; }
    asm volatile("s_waitcnt lgkmcnt(0)" ::: "memory");
    const int c = lane & 7;
#pragma unroll
    for (int j = 0; j < 4; ++j) { const int n = (lane >> 3) + 8 * j; const float* s = scr + (8 * c) * 33 + n;
        u32x4 o; o.x = pk2(s[0 * 33], s[1 * 33]); o.y = pk2(s[2 * 33], s[3 * 33]); o.z = pk2(s[4 * 33], s[5 * 33]); o.w = pk2(s[6 * 33], s[7 * 33]);
        *(u32x4*)(WT + (size_t)(drow0 + n) * K + k0 + 8 * c) = o; }
    asm volatile("s_waitcnt lgkmcnt(0)" ::: "memory");
}
__device__ __forceinline__ float cos_rev(float x) { return __builtin_amdgcn_cosf(x); }
__device__ __forceinline__ float sin_rev(float x) { return __builtin_amdgcn_sinf(x); }

__device__ __forceinline__ void prologue(KArgs a, char* lds) {
    unsigned char* ws = a->ws;
    const int tid = mytid(), lane = tid & 63, wave = tid >> 6, G = gridDim.x, bid = blockIdx.x;
    const int gt = bid * 512 + tid, GT = G * 512, gw = bid * 8 + wave, NGW = G * 8;
    if (bid == 0 && tid < 128) ((int*)(ws + WS_CTL))[tid] = 0;
    { float* sl = (float*)(lds + 73728); float* part = (float*)(lds + 73728 + 12288);
      for (int i = tid; i < 3072; i += 512) { const int cls = i >> 10, k = i & 1023; const float v = cls < 2 ? a->in[1][cls * 1024 + k] : a->in[3][k]; sl[i] = v / (1.0f + __expf(-v)); }
      __syncthreads();
      for (int item = bid; item < 384; item += G) { const int layer = item / 96, col0 = (item % 96) * 64;
          const float* Wm = a->in[4] + (size_t)layer * 1024 * 6144 + col0 + lane;
          float a0 = 0.f, a1 = 0.f, a2 = 0.f;
#pragma unroll 16
          for (int kk = 0; kk < 128; ++kk) { const int k = wave * 128 + kk; const float wv = Wm[(size_t)k * 6144]; a0 += sl[k] * wv; a1 += sl[1024 + k] * wv; a2 += sl[2048 + k] * wv; }
          part[(wave * 3 + 0) * 64 + lane] = a0; part[(wave * 3 + 1) * 64 + lane] = a1; part[(wave * 3 + 2) * 64 + lane] = a2;
          __syncthreads();
          if (tid < 192) { const int c = tid >> 6; float s = a->in[5][layer * 6144 + col0 + lane];
#pragma unroll
              for (int w8 = 0; w8 < 8; ++w8) s += part[(w8 * 3 + c) * 64 + lane];
              ((float*)(ws + WS_MODV))[((size_t)layer * 3 + c) * 6144 + col0 + lane] = s; }
          __syncthreads(); }
    }
    { float* cosC = (float*)(ws + WS_COSC); float* sinC = (float*)(ws + WS_SINC); float* cosD = (float*)(ws + WS_COSD); float* sinD = (float*)(ws + WS_SIND);
      const float L2T = 13.287712379549449f;
      for (int i = gt; i < 8192 * 64; i += GT) { const int pos = i >> 6, p = i & 63; const float rc = (p < 32) ? (float)(pos >> 6) : (float)(pos & 63);
          const float inv = exp2f(-(float)(p & 31) * (1.0f / 32.0f) * L2T), rev = rc * inv * 0.15915494309189535f; cosC[i] = cos_rev(rev); sinC[i] = sin_rev(rev); }
      for (int i = gt; i < 8192 * 32; i += GT) { const int pos = i >> 5, p = i & 31; const float rc = (p < 16) ? (float)(pos >> 6) : (float)(pos & 63);
          const float inv = exp2f(-(float)(p & 15) * (1.0f / 16.0f) * L2T), rev = rc * inv * 0.15915494309189535f; cosD[i] = cos_rev(rev); sinD[i] = sin_rev(rev); }
      bf16_t* DA = (bf16_t*)(ws + WS_DA); bf16_t* CS = (bf16_t*)(ws + WS_CS); bf16_t* W2 = (bf16_t*)(ws + WS_W2);
      const float is128 = 0.08838834764831845f;
      for (int i = gt; i < 256 * 128; i += GT) { const int j = i >> 7, c = i & 127; const float fr = (float)(((j & 127) * c) & 127) * (1.0f / 128.0f);
          const float v = (j < 128) ? cos_rev(fr) * is128 : -sin_rev(fr) * is128; DA[i] = (bf16_t)(pk2(v, 0.f) & 0xffffu); }
      for (int i = gt; i < 128 * 256; i += GT) { const int k1 = i >> 8, q = i & 255, n1 = q & 127; const float fr = (float)((k1 * n1) & 127) * (1.0f / 128.0f);
          const float v = (q < 128) ? cos_rev(fr) * is128 : sin_rev(fr) * is128; CS[i] = (bf16_t)(pk2(v, 0.f) & 0xffffu); }
      for (int i = gt; i < 64 * 128; i += GT) { const int k2 = i >> 7, q = i & 127, n2 = q & 63; const float fr = (float)((k2 * n2) & 63) * (1.0f / 64.0f);
          const float v = (q < 64) ? cos_rev(fr) * 0.125f : sin_rev(fr) * 0.125f; W2[i] = (bf16_t)(pk2(v, 0.f) & 0xffffu); }
      float* RWT = (float*)(ws + WS_RWT);
      for (int i = gt; i < 4 * 36 * 1024; i += GT) { const int l = i / (36 * 1024), rem = i - l * 36 * 1024, c = rem >> 10, k = rem & 1023;
          RWT[i] = (c < 4) ? a->in[21][((size_t)l * 1024 + k) * 4 + c] : a->in[23][((size_t)l * 1024 + k) * 32 + (c - 4)]; }
      for (int i = gt; i < 2 * 64 * 1024 / 8; i += GT) { const int j = i / (64 * 128), rem = i - j * (64 * 128);
          *(u32x4*)((bf16_t*)(ws + WS_WINCD) + (size_t)j * 1792 * 1024 + (size_t)1728 * 1024 + (size_t)rem * 8) = (u32x4){0u, 0u, 0u, 0u}; }
    }
    { float* scr = (float*)(lds + wave * 8704);
      constexpr int I0 = 2 * 768, I1 = 2 * 512, I2 = 2 * 864, I3 = 2 * 144, I4 = 2 * 128, I5 = 2 * 512, I6 = 128 * 256, I7 = 128 * 256, I8 = 128 * 256;
      constexpr int NIT = I0 + I1 + I2 + I3 + I4 + I5 + I6 + I7 + I8;
      for (int it = gw; it < NIT; it += NGW) {
          int r = it; const float* W; bf16_t* WT; int K, N, kind;
          if (r < I0) { kind = 0; const int j = r / 768; r -= j * 768; W = a->in[8] + (size_t)j * 1024 * 1536; WT = (bf16_t*)(ws + WS_WINAB) + (size_t)j * 1536 * 1024; K = 1024; N = 1536; }
          else if ((r -= I0) < I1) { kind = 1; const int j = r / 512; r -= j * 512; W = a->in[12] + (size_t)j * 1024 * 1024; WT = (bf16_t*)(ws + WS_WOUTAB) + (size_t)j * 1024 * 1024; K = 1024; N = 1024; }
          else if ((r -= I1) < I2) { kind = 1; const int j = r / 864; r -= j * 864; W = a->in[13] + (size_t)j * 1024 * 1728; WT = (bf16_t*)(ws + WS_WINCD) + (size_t)j * 1792 * 1024; K = 1024; N = 1728; }
          else if ((r -= I2) < I3) { kind = 1; const int j = r / 144; r -= j * 144; W = a->in[18] + (size_t)j * 384 * 768; WT = (bf16_t*)(ws + WS_WUQ) + (size_t)j * 768 * 384; K = 384; N = 768; }
          else if ((r -= I3) < I4) { kind = 1; const int j = r / 128; r -= j * 128; W = a->in[19] + (size_t)j * 256 * 1024; WT = (bf16_t*)(ws + WS_WUKV) + (size_t)j * 1024 * 256; K = 256; N = 1024; }
          else if ((r -= I4) < I5) { kind = 1; const int j = r / 512; r -= j * 512; W = a->in[20] + (size_t)j * 1024 * 1024; WT = (bf16_t*)(ws + WS_WOUTCD) + (size_t)j * 1024 * 1024; K = 1024; N = 1024; }
          else if ((r -= I5) < I6) { kind = 2; const int j = r >> 8; r &= 255; W = a->in[25] + (size_t)j * 1024 * 512; WT = (bf16_t*)(ws + WS_WGU) + (size_t)j * 1024 * 1024; K = 1024; N = 512; }
          else if ((r -= I6) < I7) { kind = 3; const int j = r >> 8; r &= 255; W = a->in[26] + (size_t)j * 1024 * 512; WT = (bf16_t*)(ws + WS_WGU) + (size_t)j * 1024 * 1024; K = 1024; N = 512; }
          else { r -= I7; kind = 1; const int j = r >> 8; r &= 255; W = a->in[27] + (size_t)j * 512 * 1024; WT = (bf16_t*)(ws + WS_WD) + (size_t)j * 1024 * 512; K = 512; N = 1024; }
          const int nblk = N / 32, kb = r / nblk, nb = r - kb * nblk, n0 = 32 * nb;
          int drow0 = n0;
          if (kind == 0) { if (n0 >= 512) { const int half = (n0 - 512) >> 9, q = ((n0 - 512) & 511) >> 7, rr = n0 & 127; drow0 = 512 + 256 * q + 128 * half + rr; } }
          else if (kind == 2) drow0 = 256 * (n0 >> 7) + (n0 & 127);
          else if (kind == 3) drow0 = 256 * (n0 >> 7) + 128 + (n0 & 127);
          transpose_item(W, K, N, WT, 64 * kb, n0, drow0, scr, lane);
      }
    }
}
__device__ __forceinline__ void phase_rw1(KArgs a, char* lds, int layer) {
    unsigned char* ws = a->ws; const int tid = mytid(), lane = tid & 63, wave = tid >> 6, gw = blockIdx.x * 8 + wave, NGW = gridDim.x * 8;
    float* X = (float*)(ws + WS_X); bf16_t* H = (bf16_t*)(ws + WS_H);
    int* tstart = (int*)(lds + MISC_OFF);
    if (layer > 0) compute_tstart(tstart, (const int*)(ws + WS_CTL) + (layer - 1) * 32);
    const float* modv = (const float*)(ws + WS_MODV) + (size_t)layer * 3 * 6144;
    const float* modp = (const float*)(ws + WS_MODV) + (size_t)(layer > 0 ? layer - 1 : 0) * 3 * 6144;
    for (int r = gw; r < NROWS; r += NGW) {
        const int cls = cls_of(r); f32x4 v[4];
        if (layer == 0) { load_row(r < NLAT ? a->in[0] + (size_t)r * 1024 : a->in[2] + (size_t)(r - NLAT) * 1024, lane, v); }
        else { load_row(X + (size_t)r * 1024, lane, v);
            moe_combine(v, r, lane, (const int*)(ws + WS_RES), (const float*)(ws + WS_RW), (const bf16_t*)(ws + WS_Y), tstart, modp + cls * 6144 + 5 * 1024); }
#pragma unroll
        for (int j = 0; j < 4; ++j) *(f32x4*)(X + (size_t)r * 1024 + 4 * lane + 256 * j) = v[j];
        const float rstd = row_rstd(v, lane); f32x4 h[4];
        modulate(v, rstd, lane, a->in[6] + layer * 1024, modv + cls * 6144 + 1 * 1024, modv + cls * 6144 + 0 * 1024, h);
        store_row_bf16(H + (size_t)r * 1024, lane, h);
    }
}
__device__ __forceinline__ void phase_final(KArgs a, char* lds) {
    unsigned char* ws = a->ws; const int tid = mytid(), lane = tid & 63, wave = tid >> 6, gw = blockIdx.x * 8 + wave, NGW = gridDim.x * 8;
    const float* X = (const float*)(ws + WS_X); int* tstart = (int*)(lds + MISC_OFF);
    compute_tstart(tstart, (const int*)(ws + WS_CTL) + 3 * 32);
    const float* modp = (const float*)(ws + WS_MODV) + (size_t)3 * 3 * 6144;
    for (int r = gw; r < NLAT; r += NGW) {
        const int cls = cls_of(r); f32x4 v[4]; load_row(X + (size_t)r * 1024, lane, v);
        moe_combine(v, r, lane, (const int*)(ws + WS_RES), (const float*)(ws + WS_RW), (const bf16_t*)(ws + WS_Y), tstart, modp + cls * 6144 + 5 * 1024);
        const float rstd = row_rstd(v, lane);
#pragma unroll
        for (int j = 0; j < 4; ++j) { const f32x4 g = *(const f32x4*)(a->in[28] + 4 * lane + 256 * j); *(f32x4*)(a->out + (size_t)r * 1024 + 4 * lane + 256 * j) = v[j] * rstd * g; }
    }
}
template <int CTRL, int ROW_MASK> __device__ __forceinline__ float dpp_add(float v) {
    return v + __int_as_float(__builtin_amdgcn_update_dpp(0, __float_as_int(v), CTRL, ROW_MASK, 0xf, false)); }
__device__ __forceinline__ float wave_total_hi(float v) {
    v = dpp_add<0xB1, 0xf>(v); v = dpp_add<0x4E, 0xf>(v); v = dpp_add<0x141, 0xf>(v); v = dpp_add<0x140, 0xf>(v);
    v = dpp_add<0x142, 0xa>(v); v = dpp_add<0x143, 0xc>(v); return v; }
__device__ __forceinline__ float dot4(f32x4 a, f32x4 b) { return (a[0] * b[0] + a[1] * b[1]) + (a[2] * b[2] + a[3] * b[3]); }
__device__ __forceinline__ void phase_rw2(KArgs a, char* lds, int layer, int nrows) {
    unsigned char* ws = a->ws; const int tid = mytid(), lane = tid & 63, wave = tid >> 6;
    const float* X = (const float*)(ws + WS_X); bf16_t* H = (bf16_t*)(ws + WS_H);
    const float* modv = (const float*)(ws + WS_MODV) + (size_t)layer * 3 * 6144;
    const float* RWT = (const float*)(ws + WS_RWT) + (size_t)layer * 36 * 1024;
    float* hs = (float*)lds; float* lg = (float*)(lds + 65536);
    int* cnt = (int*)(ws + WS_CTL) + layer * 32; int* res = (int*)(ws + WS_RES); float* rwt = (float*)(ws + WS_RW);
    f32x4 wr[5][4];
#pragma unroll
    for (int q = 0; q < 5; ++q) { const int c = (wave + 8 * q < 36) ? wave + 8 * q : wave;
#pragma unroll
        for (int j = 0; j < 4; ++j) wr[q][j] = *(const f32x4*)(RWT + c * 1024 + 4 * lane + 256 * j); }
    const bool has4 = wave < 4;
    for (int rg = blockIdx.x; rg < nrows / 16; rg += gridDim.x) {
#pragma unroll 1
        for (int rr = 0; rr < 2; ++rr) { const int lr = 2 * wave + rr, r = 16 * rg + lr, cls = cls_of(r);
            f32x4 v[4], h[4]; load_row(X + (size_t)r * 1024, lane, v); const float rstd = row_rstd(v, lane);
            modulate(v, rstd, lane, a->in[7] + layer * 1024, modv + cls * 6144 + 4 * 1024, modv + cls * 6144 + 3 * 1024, h);
            store_row_bf16(H + (size_t)r * 1024, lane, h);
#pragma unroll
            for (int j = 0; j < 4; ++j) *(f32x4*)(hs + lr * 1024 + 4 * lane + 256 * j) = h[j]; }
        __syncthreads();
#pragma unroll 2
        for (int r = 0; r < 16; ++r) {
            float s0 = 0.f, s1 = 0.f, s2 = 0.f, s3 = 0.f, s4 = 0.f;
#pragma unroll
            for (int j = 0; j < 4; ++j) { const f32x4 hv = *(const f32x4*)(hs + r * 1024 + 4 * lane + 256 * j);
                s0 += dot4(hv, wr[0][j]); s1 += dot4(hv, wr[1][j]); s2 += dot4(hv, wr[2][j]); s3 += dot4(hv, wr[3][j]); s4 += dot4(hv, wr[4][j]); }
            s0 = wave_total_hi(s0); s1 = wave_total_hi(s1); s2 = wave_total_hi(s2); s3 = wave_total_hi(s3); s4 = wave_total_hi(s4);
            if (lane == 63) { lg[r * 36 + wave] = s0; lg[r * 36 + wave + 8] = s1; lg[r * 36 + wave + 16] = s2; lg[r * 36 + wave + 24] = s3; if (has4) lg[r * 36 + wave + 32] = s4; }
        }
        __syncthreads();
        if (tid < 16) { const int r = 16 * rg + tid; const float* L = lg + tid * 36;
            const float* gb = a->in[22] + layer * 4; const float* eb = a->in[24] + layer * 32;
            const float g0 = L[0] + gb[0], g1 = L[1] + gb[1], g2 = L[2] + gb[2], g3 = L[3] + gb[3];
            int gi = 0; float gm = g0; if (g1 > gm) { gm = g1; gi = 1; } if (g2 > gm) { gm = g2; gi = 2; } if (g3 > gm) { gm = g3; gi = 3; }
            const float gprob = 1.0f / (expf(g0 - gm) + expf(g1 - gm) + expf(g2 - gm) + expf(g3 - gm));
            int i1 = 0; float v1 = -INFINITY;
#pragma unroll
            for (int i = 0; i < 8; ++i) { const float e = L[4 + gi * 8 + i] + eb[gi * 8 + i]; if (e > v1) { v1 = e; i1 = i; } }
            int i2 = 0; float v2 = -INFINITY;
#pragma unroll
            for (int i = 0; i < 8; ++i) { const float e = L[4 + gi * 8 + i] + eb[gi * 8 + i]; if (i != i1 && e > v2) { v2 = e; i2 = i; } }
            const float t = expf(v2 - v1), p1 = 1.0f / (1.0f + t), p2 = t / (1.0f + t);
            const int e1 = gi * 8 + i1, e2 = gi * 8 + i2;
            const int s1 = atomicAdd(cnt + e1, 1), s2 = atomicAdd(cnt + e2, 1);
            res[2 * r] = (e1 << 20) | s1; res[2 * r + 1] = (e2 << 20) | s2; rwt[2 * r] = gprob * p1; rwt[2 * r + 1] = gprob * p2; }
        __syncthreads();
    }
}
__device__ __forceinline__ void phase_gather(KArgs a, char* lds, int layer, int nrows) {
    unsigned char* ws = a->ws; const int tid = mytid(), lane = tid & 63, wave = tid >> 6, gw = blockIdx.x * 8 + wave, NGW = gridDim.x * 8;
    int* tstart = (int*)(lds + MISC_OFF); compute_tstart(tstart, (const int*)(ws + WS_CTL) + layer * 32);
    const bf16_t* H = (const bf16_t*)(ws + WS_H); bf16_t* XG = (bf16_t*)(ws + WS_XG); const int* res = (const int*)(ws + WS_RES);
    for (int r = gw; r < nrows; r += NGW) { const int es0 = res[2 * r], es1 = res[2 * r + 1];
        const size_t row0 = (size_t)tstart[es0 >> 20] * 256 + (es0 & 0xfffff), row1 = (size_t)tstart[es1 >> 20] * 256 + (es1 & 0xfffff);
        const u32x4 x0 = *(const u32x4*)(H + (size_t)r * 1024 + 8 * lane), x1 = *(const u32x4*)(H + (size_t)r * 1024 + 512 + 8 * lane);
        *(u32x4*)(XG + row0 * 1024 + 8 * lane) = x0; *(u32x4*)(XG + row0 * 1024 + 512 + 8 * lane) = x1;
        *(u32x4*)(XG + row1 * 1024 + 8 * lane) = x0; *(u32x4*)(XG + row1 * 1024 + 512 + 8 * lane) = x1; }
}
__device__ __forceinline__ void ld8f(const bf16_t* p, float (&f)[8]) { const u32x4 w = *(const u32x4*)p; f[0] = bf_lo(w.x); f[1] = bf_hi(w.x); f[2] = bf_lo(w.y); f[3] = bf_hi(w.y); f[4] = bf_lo(w.z); f[5] = bf_hi(w.z); f[6] = bf_lo(w.w); f[7] = bf_hi(w.w); }
__device__ __forceinline__ void st8f(bf16_t* p, const float (&f)[8]) { u32x4 w; w.x = pk2(f[0], f[1]); w.y = pk2(f[2], f[3]); w.z = pk2(f[4], f[5]); w.w = pk2(f[6], f[7]); *(u32x4*)p = w; }
__device__ __forceinline__ float sumsq8(const float (&f)[8]) { return (f[0] * f[0] + f[1] * f[1]) + (f[2] * f[2] + f[3] * f[3]) + (f[4] * f[4] + f[5] * f[5]) + (f[6] * f[6] + f[7] * f[7]); }
__device__ __forceinline__ void scale_g8(float (&f)[8], float rstd, const float* g) { const f32x4 g0 = *(const f32x4*)g, g1 = *(const f32x4*)(g + 4);
    f[0] *= rstd * g0[0]; f[1] *= rstd * g0[1]; f[2] *= rstd * g0[2]; f[3] *= rstd * g0[3]; f[4] *= rstd * g1[0]; f[5] *= rstd * g1[1]; f[6] *= rstd * g1[2]; f[7] *= rstd * g1[3]; }
__device__ __forceinline__ void rope8(float (&f)[8], const float* cs, const float* sn) { const f32x4 c = *(const f32x4*)cs, s = *(const f32x4*)sn;
#pragma unroll
    for (int i = 0; i < 4; ++i) { const float xr = f[2 * i], xi = f[2 * i + 1]; f[2 * i] = xr * c[i] - xi * s[i]; f[2 * i + 1] = xr * s[i] + xi * c[i]; } }
__device__ __forceinline__ void phase_qkvpost(KArgs a, int j) {
    unsigned char* ws = a->ws; const int tid = mytid(), lane = tid & 63, wave = tid >> 6, gw = blockIdx.x * 8 + wave, NGW = gridDim.x * 8;
    const bf16_t* P = (const bf16_t*)(ws + WS_P);
    bf16_t* Qc = (bf16_t*)(ws + WS_QC); bf16_t* Kc = (bf16_t*)(ws + WS_KC); bf16_t* Vc = (bf16_t*)(ws + WS_VC); bf16_t* CQ = (bf16_t*)(ws + WS_CQ); bf16_t* CKV = (bf16_t*)(ws + WS_CKV); bf16_t* Kdr = (bf16_t*)(ws + WS_KDR);
    const float* cosC = (const float*)(ws + WS_COSC); const float* sinC = (const float*)(ws + WS_SINC); const float* cosD = (const float*)(ws + WS_COSD); const float* sinD = (const float*)(ws + WS_SIND);
    const float* qg = a->in[14] + j * 128; const float* kg = a->in[15] + j * 128; const float* cqg = a->in[16] + j * 384; const float* ckvg = a->in[17] + j * 256;
    for (int r = gw; r < NROWS; r += NGW) {
        const bf16_t* Pr = P + (size_t)r * 1792; const bool rot = r < NLAT; const int pos = r & 8191; const size_t kr = (size_t)pg8::keyrow_of(r);
        float f[8];
        { ld8f(Pr + 8 * lane, f); float s = sumsq8(f); s += shx(s, lane, 1); s += shx(s, lane, 2); s += shx(s, lane, 4); s += shx(s, lane, 8);
          const int d = (8 * lane) & 127; scale_g8(f, rsqrtf(s * (1.0f / 128.0f) + EPS), qg + d);
          if (rot) rope8(f, cosC + pos * 64 + (d >> 1), sinC + pos * 64 + (d >> 1));
          st8f(Qc + (size_t)r * 512 + 8 * lane, f); }
        { ld8f(Pr + 512 + 8 * lane, f); float s = sumsq8(f); s += shx(s, lane, 1); s += shx(s, lane, 2); s += shx(s, lane, 4); s += shx(s, lane, 8);
          if (lane < 32) { const int d = (8 * lane) & 127; scale_g8(f, rsqrtf(s * (1.0f / 128.0f) + EPS), kg + d);
              if (rot) rope8(f, cosC + pos * 64 + (d >> 1), sinC + pos * 64 + (d >> 1));
              st8f(Kc + kr * 256 + 8 * lane, f); }
          else st8f(Vc + kr * 256 + 8 * (lane - 32), f); }
        { const int off = lane < 48 ? 1024 + 8 * lane : (lane < 56 ? 1664 + 8 * (lane - 48) : 0); ld8f(Pr + off, f);
          float s = lane < 48 ? sumsq8(f) : 0.f; s = wave_sum(s, lane);
          if (lane < 48) { scale_g8(f, rsqrtf(s * (1.0f / 384.0f) + EPS), cqg + 8 * lane); st8f(CQ + (size_t)r * 384 + 8 * lane, f); }
          else if (lane < 56) { if (rot) rope8(f, cosD + pos * 32 + 4 * (lane - 48), sinD + pos * 32 + 4 * (lane - 48)); st8f(Kdr + kr * 64 + 8 * (lane - 48), f); } }
        { const int off = 1408 + 8 * (lane & 31); ld8f(Pr + off, f); float s = lane < 32 ? sumsq8(f) : 0.f; s = wave_sum(s, lane);
          if (lane < 32) { scale_g8(f, rsqrtf(s * (1.0f / 256.0f) + EPS), ckvg + 8 * lane); st8f(CKV + (size_t)r * 256 + 8 * lane, f); } }
    }
}
__global__ void __launch_bounds__(512, 2) fwd_kernel(Args a_unused) {
    extern __shared__ __attribute__((aligned(16))) unsigned char lds_raw[];
    cg::grid_group grid = cg::this_grid();
    char* lds = (char*)lds_raw; PG8_LAS unsigned char* lds3 = (PG8_LAS unsigned char*)lds_raw;
    const int G = gridDim.x, bid = blockIdx.x;
    const int lo = kargs()->ph_lo, hi = kargs()->ph_hi; int ph = 0;
    { volatile LAS unsigned* st_ = (volatile LAS unsigned*)(lds3 + MISC_OFF + 256); if (threadIdx.x == 0) { st_[0] = 0u; st_[1] = 0u; } __syncthreads();
      (void)xcd_barrier_post((unsigned*)(kargs()->ws + WS_CTL) + 4096, st_); }
#ifdef ZERO_LDS
    for (int i = mytid(); i < LDS_BYTES / 16; i += 512) *(u32x4*)(lds + i * 16) = (u32x4){0u, 0u, 0u, 0u};
    __syncthreads();
#endif
#define a kargs()
#define ws (kargs()->ws)
#ifndef PHSEL
#define PHSEL -1
#endif
#define RUNK(k) (ph >= lo && ph < hi && (PHSEL < 0 || PHSEL == (k)))
#ifndef PROBE_KIND
#define PROBE_KIND -1
#endif
#ifndef PROBE_MASK
#define PROBE_MASK 0
#endif
#define NREP(k) (((k) == PROBE_KIND || ((PROBE_MASK >> (k)) & 1)) ? 2 : 1)
#define SEAM() do { ++ph; if (ph > lo && ph < hi) { if (ph == 1) { asm volatile("s_waitcnt vmcnt(0) lgkmcnt(0)" ::: "memory"); grid.sync(); } \
    else { XcdBarrier xb_; xb_.bar = (unsigned*)(ws + WS_CTL) + 4096; xb_.x = xb_xcc_id(); xb_.st = (volatile LAS unsigned*)(lds3 + MISC_OFF + 256); xcd_barrier(xb_); } } } while (0)
#define H ((bf16_t*)(ws + WS_H))
#define MIX ((bf16_t*)(ws + WS_MIX))
#define X ((float*)(ws + WS_X))
    for (int rep_ = 0; rep_ < NREP(0); ++rep_) if (RUNK(0)) prologue(a, lds);
    SEAM();
#pragma unroll 1
    for (int layer = 0; layer < 4; ++layer) {
        const int j = layer >> 1; const bool last = layer == 3;
#define modv ((const float*)(ws + WS_MODV) + (size_t)layer * 3 * 6144)
        for (int rep_ = 0; rep_ < NREP(1); ++rep_) if (RUNK(1)) phase_rw1(a, lds, layer);
        SEAM();
        if ((layer & 1) == 0) {
            bf16_t* PA = (bf16_t*)(ws + WS_P); bf16_t* U = PA + (size_t)NROWS * 512;
            for (int rep_ = 0; rep_ < NREP(2); ++rep_) if (RUNK(2)) { pg8::Gemm g{H, (const bf16_t*)(ws + WS_WINAB) + (size_t)j * 1536 * 1024, NROWS, 1536, 1024}; pg8::StaticOrder S; S.init(NROWS, 1536, G, bid);
                pg8::EpiInAB E{PA, U}; pg8::gemm_phase<pg8::EpiInAB, pg8::StaticOrder, true, true>(lds3, g, S, E); }
            SEAM();
            for (int rep_ = 0; rep_ < NREP(3); ++rep_) if (RUNK(3)) {
                const bf16_t* DA = (const bf16_t*)(ws + WS_DA); const bf16_t* CS = (const bf16_t*)(ws + WS_CS);
                for (int it = bid; it < 1056; it += G) {
                    if (it < 512) { const int seqg = it >> 6, n2 = it & 63, b = seqg >> 2, gq = seqg & 3; fx::f1_item(lds, PA, DA, CS, (bf16_t*)(ws + WS_T), b * SEQ + n2, 64, gq, n2, 64, 8192, seqg); }
                    else if (it < 528) { const int q = it - 512, seqg = q >> 1, n2 = q & 1, b = seqg >> 2, gq = seqg & 3; fx::f1_item(lds, PA, DA, CS, (bf16_t*)(ws + WS_TC), NLAT + b * CTXL + n2, 2, gq, n2, 2, 256, seqg); }
                    else { const int t0 = (it - 528) * 32; int s0, s1; if (t0 < NLAT) { s0 = t0 & ~(SEQ - 1); s1 = s0 + SEQ; } else { s0 = NLAT + ((t0 - NLAT) & ~(CTXL - 1)); s1 = s0 + CTXL; }
#ifndef NO_CONV
                        fx::conv_item(lds, U, a->in[9] + (size_t)j * 31 * 512, a->in[10] + j * 512, a->in[11] + j * 512, MIX, t0, s0, s1);
#endif
 }
                }
            }
            SEAM();
            for (int rep_ = 0; rep_ < NREP(4); ++rep_) if (RUNK(4)) {
                const bf16_t* W2 = (const bf16_t*)(ws + WS_W2); bool first = true;
                for (int it = bid; it < 1024; it += G) { fx::f2_item(lds, (const bf16_t*)(ws + WS_T), W2, MIX, it >> 7, it & 127, first); first = false; }
                const bf16_t* TC = (const bf16_t*)(ws + WS_TC);
                for (int i = bid * 512 + mytid(); i < 8 * 128 * 32; i += G * 512) { const int seqg = i >> 12, k1 = (i >> 5) & 127, m0 = (i & 31) * 4, b = seqg >> 2, gq = seqg & 3;
                    const u32x2 t0 = *(const u32x2*)(TC + ((size_t)(seqg * 128 + k1) * 2 + 0) * 256 + m0), t1 = *(const u32x2*)(TC + ((size_t)(seqg * 128 + k1) * 2 + 1) * 256 + m0);
                    const float r2 = 0.7071067811865476f; u32x2 o0, o1;
                    o0.x = pk2((bf_lo(t0.x) + bf_lo(t1.x)) * r2, (bf_hi(t0.x) + bf_hi(t1.x)) * r2); o0.y = pk2((bf_lo(t0.y) + bf_lo(t1.y)) * r2, (bf_hi(t0.y) + bf_hi(t1.y)) * r2);
                    o1.x = pk2((bf_lo(t0.x) - bf_lo(t1.x)) * r2, (bf_hi(t0.x) - bf_hi(t1.x)) * r2); o1.y = pk2((bf_lo(t0.y) - bf_lo(t1.y)) * r2, (bf_hi(t0.y) - bf_hi(t1.y)) * r2);
                    *(u32x2*)(MIX + (size_t)(NLAT + b * CTXL + k1) * 1024 + gq * 128 + m0) = o0; *(u32x2*)(MIX + (size_t)(NLAT + b * CTXL + k1 + 128) * 1024 + gq * 128 + m0) = o1; }
            }
            SEAM();
            for (int rep_ = 0; rep_ < NREP(5); ++rep_) if (RUNK(5)) { pg8::Gemm g{MIX, (const bf16_t*)(ws + WS_WOUTAB) + (size_t)j * 1024 * 1024, NROWS, 1024, 1024}; pg8::StaticOrder S; S.init(NROWS, 1024, G, bid);
                pg8::EpiRes E{X, modv + 2 * 1024}; pg8::gemm_phase<pg8::EpiRes, pg8::StaticOrder, true, true>(lds3, g, S, E); }
            SEAM();
        } else {
            bf16_t* P = (bf16_t*)(ws + WS_P);
            for (int rep_ = 0; rep_ < NREP(6); ++rep_) if (RUNK(6)) { pg8::Gemm g{H, (const bf16_t*)(ws + WS_WINCD) + (size_t)j * 1792 * 1024, NROWS, 1792, 1024}; pg8::StaticOrder S; S.init(NROWS, 1792, G, bid);
                pg8::EpiPlain E{P, 1792}; pg8::gemm_phase<pg8::EpiPlain, pg8::StaticOrder, true, true>(lds3, g, S, E); }
            SEAM();
            for (int rep_ = 0; rep_ < NREP(7); ++rep_) if (RUNK(7)) phase_qkvpost(a, j);
            SEAM();
            for (int rep_ = 0; rep_ < NREP(8); ++rep_) if (RUNK(8)) {
#ifndef NO_UQ
                { pg8::Gemm g{(const bf16_t*)(ws + WS_CQ), (const bf16_t*)(ws + WS_WUQ) + (size_t)j * 768 * 384, NROWS, 768, 384}; pg8::StaticOrder S; S.init(NROWS, 768, G, bid);
                  pg8::EpiUq E{(bf16_t*)(ws + WS_QD), (const float*)(ws + WS_COSD), (const float*)(ws + WS_SIND)}; pg8::gemm_phase<pg8::EpiUq, pg8::StaticOrder, true, true>(lds3, g, S, E); }
#endif
#ifndef NO_UKV
                { pg8::Gemm g{(const bf16_t*)(ws + WS_CKV), (const bf16_t*)(ws + WS_WUKV) + (size_t)j * 1024 * 256, NROWS, 1024, 256}; pg8::StaticOrder S; S.init(NROWS, 1024, G, bid);
                  pg8::EpiUkv E{(bf16_t*)(ws + WS_KDN), (bf16_t*)(ws + WS_VD)}; pg8::gemm_phase<pg8::EpiUkv, pg8::StaticOrder, true, true>(lds3, g, S, E); }
#endif
            }
            SEAM();
            for (int rep_ = 0; rep_ < NREP(9); ++rep_) if (RUNK(9)) {
                using att::bf16;
                const bf16* Qc = (const bf16*)(ws + WS_QC); const bf16* Kc = (const bf16*)(ws + WS_KC); const bf16* Vc = (const bf16*)(ws + WS_VC);
                const bf16* QD = (const bf16*)(ws + WS_QD); const bf16* Kdn = (const bf16*)(ws + WS_KDN); const bf16* Kdr = (const bf16*)(ws + WS_KDR); const bf16* Vd = (const bf16*)(ws + WS_VD);
                bf16* AO = (bf16*)MIX;
#ifndef NO_GQA
#pragma unroll 1
                for (int c = bid; c < 256; c += G) { const int bh = c & 7, qb = c >> 3, b = bh >> 2, h = bh & 3; const size_t qrow = (size_t)b * SEQ + qb * 256, krow = (size_t)b * KEYS;
                    att::attn_unit_simple<false, 512, 256, 1024>(Qc + qrow * 512 + h * 128, Kc + krow * 256 + (h >> 1) * 128, nullptr, Vc + krow * 256 + (h >> 1) * 128, AO + qrow * 1024 + h * 128, KEYS, lds); }
#endif
                asm volatile("" ::: "memory");
#ifndef NO_MLA
#pragma unroll 1
                for (int c = bid; c < 256; c += G) { const int bh = c & 7, qb = c >> 3, b = bh >> 2, h = bh & 3; const size_t qrow = (size_t)b * SEQ + qb * 256, krow = (size_t)b * KEYS;
                    att::attn_unit_simple<true, 768, 512, 1024>(QD + qrow * 768 + h * 192, Kdn + krow * 512 + h * 128, Kdr + krow * 64, Vd + krow * 512 + h * 128, AO + qrow * 1024 + 512 + h * 128, KEYS, lds); }
#endif
                asm volatile("" ::: "memory");
#ifndef NO_CTXQ
                if (!last)
#pragma unroll 1
                for (int c = bid; c < 16; c += G) { const int bh = c & 7, b = bh >> 2, h = bh & 3; const size_t qrow = (size_t)NLAT + b * CTXL, krow = (size_t)b * KEYS;
                    if (c < 8) att::attn_unit_simple<false, 512, 256, 1024>(Qc + qrow * 512 + h * 128, Kc + krow * 256 + (h >> 1) * 128, nullptr, Vc + krow * 256 + (h >> 1) * 128, AO + qrow * 1024 + h * 128, CTXL, lds);
                    else att::attn_unit_simple<true, 768, 512, 1024>(QD + qrow * 768 + h * 192, Kdn + krow * 512 + h * 128, Kdr + krow * 64, Vd + krow * 512 + h * 128, AO + qrow * 1024 + 512 + h * 128, CTXL, lds); }
#endif
            }
            SEAM();
            for (int rep_ = 0; rep_ < NREP(10); ++rep_) if (RUNK(10)) { pg8::Gemm g{MIX, (const bf16_t*)(ws + WS_WOUTCD) + (size_t)j * 1024 * 1024, NROWS, 1024, 1024}; pg8::StaticOrder S; S.init(last ? NLAT : NROWS, 1024, G, bid);
                pg8::EpiRes E{X, modv + 2 * 1024}; pg8::gemm_phase<pg8::EpiRes, pg8::StaticOrder, true, true>(lds3, g, S, E); }
            SEAM();
        }
        const int nrows = last ? NLAT : NROWS;
        for (int rep_ = 0; rep_ < NREP(11); ++rep_) if (RUNK(11)) phase_rw2(a, lds, layer, nrows);
        SEAM();
        for (int rep_ = 0; rep_ < NREP(12); ++rep_) if (RUNK(12)) phase_gather(a, lds, layer, nrows);
        SEAM();
        for (int rep_ = 0; rep_ < NREP(13); ++rep_) if (RUNK(13)) { int* tstart = (int*)(lds + MISC_OFF); compute_tstart(tstart, (const int*)(ws + WS_CTL) + layer * 32);
            pg8::GroupedOrder S{(const PG8_LAS int*)(lds3 + MISC_OFF), tstart[32], G, bid};
            pg8::Gemm g{(const bf16_t*)(ws + WS_XG), (const bf16_t*)(ws + WS_WGU) + (size_t)layer * 32 * 1024 * 1024, 0, 1024, 1024};
            pg8::EpiGU E{(bf16_t*)(ws + WS_HID)}; pg8::gemm_phase<pg8::EpiGU, pg8::GroupedOrder, true, true>(lds3, g, S, E); }
        SEAM();
        for (int rep_ = 0; rep_ < NREP(14); ++rep_) if (RUNK(14)) { int* tstart = (int*)(lds + MISC_OFF); compute_tstart(tstart, (const int*)(ws + WS_CTL) + layer * 32);
            pg8::GroupedOrder S{(const PG8_LAS int*)(lds3 + MISC_OFF), tstart[32], G, bid};
            pg8::Gemm g{(const bf16_t*)(ws + WS_HID), (const bf16_t*)(ws + WS_WD) + (size_t)layer * 32 * 1024 * 512, 0, 1024, 512};
            pg8::EpiPlain E{(bf16_t*)(ws + WS_Y), 1024}; pg8::gemm_phase<pg8::EpiPlain, pg8::GroupedOrder, true, true>(lds3, g, S, E); }
        SEAM();
    }
#ifdef PROBE_SYNC
    for (int i_ = 0; i_ < PROBE_SYNC; ++i_) { asm volatile("s_waitcnt vmcnt(0) lgkmcnt(0)" ::: "memory"); grid.sync(); }
#endif
#ifdef DBG_STOP
    { asm volatile("s_waitcnt vmcnt(0) lgkmcnt(0)" ::: "memory"); grid.sync();
#ifdef DBG_BF16_OFF
      const bf16_t* Bs = (const bf16_t*)(ws + (size_t)(DBG_BF16_OFF));
      for (size_t i = (size_t)bid * 512 + mytid(); i < (size_t)NLAT * 256; i += (size_t)G * 512) { const u32x2 w = *(const u32x2*)(Bs + i * 4); *(f32x4*)(a->out + i * 4) = (f32x4){bf_lo(w.x), bf_hi(w.x), bf_lo(w.y), bf_hi(w.y)}; }
#else
      const float* Xs = (const float*)(ws + WS_X);
      for (size_t i = (size_t)bid * 512 + mytid(); i < (size_t)NLAT * 256; i += (size_t)G * 512) *(f32x4*)(a->out + i * 4) = *(const f32x4*)(Xs + i * 4);
#endif
    }
#else
    for (int rep_ = 0; rep_ < NREP(15); ++rep_) if (RUNK(15)) phase_final(a, lds);
#endif
#undef RUNK
#undef SEAM
#undef a
#undef ws
#undef H
#undef MIX
#undef X
#undef modv
}
constexpr int N_PHASES = 1 + 2 * 9 + 2 * 10 + 1;

extern "C" void kernel_launch(void* const* d_in, const int* in_sizes, int n_in, void* d_out, int out_size, void* d_ws, size_t ws_size, hipStream_t stream) {
    static int grid = 0;
    if (grid == 0) {
        if (n_in != 29 || out_size != NLAT * 1024 || ws_size < WS_END) { fprintf(stderr, "kernel_launch: unexpected shapes: n_in %d out %d ws %zu (need %zu)\n", n_in, out_size, ws_size, (size_t)WS_END); grid = -1; return; }
        int dev = 0, cus = 0, per_cu = 0;
        if (hipGetDevice(&dev) != hipSuccess || hipDeviceGetAttribute(&cus, hipDeviceAttributeMultiprocessorCount, dev) != hipSuccess) { grid = -1; return; }
        if (hipFuncSetAttribute((const void*)fwd_kernel, hipFuncAttributeMaxDynamicSharedMemorySize, LDS_BYTES) != hipSuccess) { fprintf(stderr, "kernel_launch: hipFuncSetAttribute failed\n"); grid = -1; return; }
        if (hipOccupancyMaxActiveBlocksPerMultiprocessor(&per_cu, (const void*)fwd_kernel, 512, LDS_BYTES) != hipSuccess || per_cu < 1) { fprintf(stderr, "kernel_launch: occupancy query says %d blocks per CU\n", per_cu); (void)hipGetLastError(); grid = -1; return; }
        grid = cus;
    }
    if (grid < 0) return;
    if (hipMemsetAsync((char*)d_ws + WS_CTL, 0, 65536, stream) != hipSuccess) { fprintf(stderr, "kernel_launch: hipMemsetAsync failed\n"); return; }
    Args a{};
    for (int i = 0; i < 29; ++i) a.in[i] = (const float*)d_in[i];
    a.out = (float*)d_out; a.ws = (unsigned char*)d_ws; a.ph_lo = 0; a.ph_hi = N_PHASES;
#ifdef DBG_STOP
    a.ph_hi = DBG_STOP;
#endif
    void* args[] = {&a};
    const hipError_t e = hipLaunchCooperativeKernel((const void*)fwd_kernel, dim3(grid), dim3(512), args, LDS_BYTES, stream);
    if (e != hipSuccess) fprintf(stderr, "kernel_launch: cooperative launch failed: %s (grid %d)\n", hipGetErrorString(e), grid);
}
```
